# Optimizing an MI355X kernel written in HIP

```python
import math, functools
import jax, jax.numpy as jnp
from jax import lax
import numpy as np

D_MODEL = 1024
BATCH = 16
SEQ = 256
DEPTH = 2
DEC_BATCH = 4
DEC_SEQ = 4096
PAST_LEN = 512

GRID_W = 64
N_MOD = 9
D_FF = 2816
EPS = 1e-6
ROPE_BASE = 10000.0
MLA_HEADS = 8
MLA_Q_LORA = 256
MLA_KV_LORA = 128
MLA_NOPE = 64
MLA_ROPE = 32
MLA_V = 64
MLA_QK = MLA_NOPE + MLA_ROPE
ATTN_Q_BLOCK = 128
RET_HEADS = 4
RET_DK = 128
RET_DV = 128
RET_CHUNK = 128
POOL_WINDOWS = (2, 4, 8, 16)
POOL_GROUPS = 4
POOL_GROUP_W = 128
POOL_W = POOL_GROUPS * POOL_GROUP_W
IN_SPLITS = (D_MODEL, D_MODEL, D_MODEL, MLA_Q_LORA, MLA_KV_LORA, MLA_ROPE,
             RET_HEADS * RET_DK, RET_HEADS * RET_DK, RET_HEADS * RET_DV, RET_HEADS * RET_DV, POOL_W)
IN_W = sum(IN_SPLITS)

kernel_name = 'hybrid_diffusion_mla_retention_pool_step'


def rms_norm(x, gain=None):
    xf = x.astype(jnp.float32)
    y = xf * lax.rsqrt(jnp.mean(xf * xf, axis=-1, keepdims=True) + EPS)
    if gain is not None:
        y = y * gain.astype(jnp.float32)
    return y.astype(x.dtype)


def rope(x, pos):
    d = x.shape[-1]
    half = d // 2
    inv = ROPE_BASE ** (-jnp.arange(half, dtype=jnp.float32) / half)
    ang = pos.astype(jnp.float32)[:, None] * inv[None, :]
    shape = (1, pos.shape[0]) + (1,) * (x.ndim - 3) + (half,)
    cos = jnp.cos(ang).reshape(shape)
    sin = jnp.sin(ang).reshape(shape)
    xf = x.astype(jnp.float32)
    x1, x2 = xf[..., :half], xf[..., half:]
    return jnp.concatenate([x1 * cos - x2 * sin, x1 * sin + x2 * cos], axis=-1).astype(x.dtype)


def axial_rope(x, row, col):
    half = x.shape[-1] // 2
    return jnp.concatenate([rope(x[..., :half], row), rope(x[..., half:], col)], axis=-1)


def grid_positions(n):
    rows = n // GRID_W
    row = jnp.repeat(jnp.arange(rows), GRID_W)
    col = jnp.arange(rows * GRID_W) % GRID_W
    return row, col


def split_in(z):
    offs = np.cumsum(IN_SPLITS)[:-1].tolist()
    return jnp.split(z, offs, axis=-1)


def swiglu(h, w_gu, w_down):
    g, u = jnp.split(h @ w_gu, 2, axis=-1)
    return (jax.nn.silu(g) * u) @ w_down


def block_attention(q, k, v):
    B, n, H, dq = q.shape
    nb = n // ATTN_Q_BLOCK
    qb = q.reshape(B, nb, ATTN_Q_BLOCK, H, dq).swapaxes(0, 1)
    scale = dq ** -0.5

    def one(qblk):
        s = jnp.einsum('bqhd,bkhd->bhqk', qblk, k).astype(jnp.float32) * scale
        p = jax.nn.softmax(s, axis=-1).astype(v.dtype)
        return jnp.einsum('bhqk,bkhe->bqhe', p, v)

    o = lax.map(one, qb)
    return o.swapaxes(0, 1).reshape(B, n, H, v.shape[-1])


def mla_queries(qc, q_norm, w_uq):
    B, n = qc.shape[:2]
    return (rms_norm(qc, q_norm) @ w_uq).reshape(B, n, MLA_HEADS, MLA_QK)


def mla_keys_values(ckv, kr, w_ukv):
    B, n = ckv.shape[:2]
    kv = (ckv @ w_ukv).reshape(B, n, MLA_HEADS, MLA_NOPE + MLA_V)
    k = jnp.concatenate([kv[..., :MLA_NOPE],
                         jnp.broadcast_to(kr[:, :, None, :], (B, n, MLA_HEADS, MLA_ROPE)).astype(kv.dtype)], axis=-1)
    return k, kv[..., MLA_NOPE:]


def retention_heads(rq, rk, rv):
    B, n = rq.shape[:2]
    q = rq.reshape(B, n, RET_HEADS, RET_DK).astype(jnp.float32)
    k = rk.reshape(B, n, RET_HEADS, RET_DK).astype(jnp.float32) * RET_DK ** -0.5
    v = rv.reshape(B, n, RET_HEADS, RET_DV).astype(jnp.float32)
    return q, k, v


def retention_scan(q, k, v, log_gamma, state0):
    B, n, H, _ = q.shape
    nc = n // RET_CHUNK

    def chunks(a):
        return a.reshape(B, nc, RET_CHUNK, H, a.shape[-1]).swapaxes(0, 1)

    idx = jnp.arange(RET_CHUNK, dtype=jnp.float32)
    diff = idx[:, None] - idx[None, :]
    decay = jnp.where(diff >= 0, jnp.exp(jnp.maximum(diff, 0.0)[None] * log_gamma[:, None, None]), 0.0)
    q_decay = jnp.exp((idx[:, None] + 1.0) * log_gamma[None, :])
    k_decay = jnp.exp((RET_CHUNK - 1.0 - idx[:, None]) * log_gamma[None, :])
    chunk_decay = jnp.exp(RET_CHUNK * log_gamma)

    def step(S, blk):
        qc, kc, vc = blk
        s = jnp.einsum('bihd,bjhd->bhij', qc, kc) * decay[None]
        inner = jnp.einsum('bhij,bjhe->bihe', s, vc)
        cross = jnp.einsum('bihd,bhde->bihe', qc, S) * q_decay[None, :, :, None]
        S = S * chunk_decay[None, :, None, None] + jnp.einsum('bjhd,bjhe->bhde', kc * k_decay[None, :, :, None], vc)
        return S, inner + cross

    S, out = lax.scan(step, state0, (chunks(q), chunks(k), chunks(v)))
    return out.swapaxes(0, 1).reshape(B, n, H, v.shape[-1]), S


def bidir_retention(q, k, v, ret_decay, state0):
    log_gamma = -jnp.exp(ret_decay.astype(jnp.float32))
    state0 = state0.astype(jnp.float32)
    o_f, s_f = retention_scan(q, k, v, log_gamma[0], state0[:, 0])
    o_b, s_b = retention_scan(jnp.flip(q, 1), jnp.flip(k, 1), jnp.flip(v, 1), log_gamma[1], state0[:, 1])
    return o_f + jnp.flip(o_b, 1), jnp.stack([s_f, s_b], axis=1)


def retention_out(o, rg):
    B, n = o.shape[:2]
    o = o * lax.rsqrt(jnp.mean(o * o, axis=-1, keepdims=True) + EPS)
    return jax.nn.silu(rg) * o.reshape(B, n, RET_HEADS * RET_DV).astype(rg.dtype)


def multiscale_pool(u, pool_w, pool_scale):
    B, n, _ = u.shape
    ug = u.reshape(B, n, POOL_GROUPS, POOL_GROUP_W).astype(jnp.float32)
    cs = jnp.concatenate([jnp.zeros_like(ug[:, :1]), jnp.cumsum(ug, axis=1)], axis=1)
    t = jnp.arange(n)[:, None]
    half = jnp.array(POOL_WINDOWS, dtype=jnp.int32)[None, :] // 2
    lo = jnp.clip(t - half, 0, n)
    hi = jnp.clip(t + half, 0, n)
    grp = jnp.arange(POOL_GROUPS)[None, :]
    win_sum = cs[:, hi, grp] - cs[:, lo, grp]
    mean = win_sum / (hi - lo).astype(jnp.float32)[None, :, :, None]
    y = (mean - ug).astype(u.dtype)
    y = jnp.einsum('bngc,gcd->bngd', y, pool_w).reshape(B, n, POOL_W)
    return y * pool_scale


def merge_branches(ga, gb, gc, oa, ob, oc, lp):
    B, n = oa.shape[:2]
    y = (jax.nn.sigmoid(ga) * (oa.reshape(B, n, MLA_HEADS * MLA_V) @ lp['w_branch_attn'])
         + jax.nn.sigmoid(gb) * (ob @ lp['w_branch_ret'])
         + jax.nn.sigmoid(gc) * (oc @ lp['w_branch_pool']))
    return y @ lp['w_out']


def mixer_context(h, lp):
    B, n, _ = h.shape
    ga, gb, gc, qc, kvc, kr, rq, rk, rv, rg, pu = split_in(h @ lp['w_in'])
    q = mla_queries(qc, lp['mla_q_norm'], lp['mla_w_uq'])
    ckv = rms_norm(kvc, lp['mla_kv_norm'])
    k, v = mla_keys_values(ckv, kr, lp['mla_w_ukv'])
    oa = block_attention(q, k, v)
    qr, krr, vr = retention_heads(rq, rk, rv)
    zero = jnp.zeros((B, 2, RET_HEADS, RET_DK, RET_DV), jnp.float32)
    o_r, st = bidir_retention(qr, krr, vr, lp['ret_decay'], zero)
    ob = retention_out(o_r, rg)
    oc = multiscale_pool(pu, lp['pool_w'], lp['pool_scale'])
    return merge_branches(ga, gb, gc, oa, ob, oc, lp), (ckv, kr, st)


def mixer_latent(h, ckv_ctx, kr_ctx, st_ctx, lp):
    B, n, _ = h.shape
    row, col = grid_positions(n)
    t = jnp.arange(n)
    ga, gb, gc, qc, kvc, kr, rq, rk, rv, rg, pu = split_in(h @ lp['w_in'])
    q = mla_queries(qc, lp['mla_q_norm'], lp['mla_w_uq'])
    q = jnp.concatenate([q[..., :MLA_NOPE], axial_rope(q[..., MLA_NOPE:], row, col)], axis=-1)
    k_lat, v_lat = mla_keys_values(rms_norm(kvc, lp['mla_kv_norm']), axial_rope(kr, row, col), lp['mla_w_ukv'])
    k_ctx, v_ctx = mla_keys_values(ckv_ctx.astype(h.dtype), kr_ctx.astype(h.dtype), lp['mla_w_ukv'])
    oa = block_attention(q, jnp.concatenate([k_lat, k_ctx], axis=1), jnp.concatenate([v_lat, v_ctx], axis=1))
    qr, krr, vr = retention_heads(rq, rk, rv)
    o_r, _ = bidir_retention(rope(qr, t), rope(krr, t), vr, lp['ret_decay'], st_ctx)
    ob = retention_out(o_r, rg)
    oc = multiscale_pool(pu, lp['pool_w'], lp['pool_scale'])
    return merge_branches(ga, gb, gc, oa, ob, oc, lp), ()


def trunk_layer(x, cvec, lp, mixer):
    mod = (jax.nn.silu(cvec) @ lp['w_ada'] + lp['b_ada']).reshape(cvec.shape[0], 1, N_MOD, D_MODEL)
    h = rms_norm(x, lp['norm_pre'][0]) * (1 + mod[:, :, 1]) + mod[:, :, 0]
    x = x + 0.5 * mod[:, :, 2] * rms_norm(swiglu(h, lp['ffn1_w_gu'], lp['ffn1_w_down']), lp['norm_post'][0])
    h = rms_norm(x, lp['norm_pre'][1]) * (1 + mod[:, :, 4]) + mod[:, :, 3]
    y, ctx_out = mixer(h)
    x = x + mod[:, :, 5] * rms_norm(y, lp['norm_post'][1])
    h = rms_norm(x, lp['norm_pre'][2]) * (1 + mod[:, :, 7]) + mod[:, :, 6]
    x = x + 0.5 * mod[:, :, 8] * rms_norm(swiglu(h, lp['ffn2_w_gu'], lp['ffn2_w_down']), lp['norm_post'][2])
    return x, ctx_out


def setup_inputs(seed: int = 0) -> dict:
    key = jax.random.key(seed)
    ks = jax.random.split(key, 27)
    f32 = jnp.float32
    L, D = DEPTH, D_MODEL

    def nrm(i, shape, scale):
        return scale * jax.random.normal(ks[i], shape, f32)

    ret_base = -(5.0 + jnp.arange(RET_HEADS, dtype=f32)) * math.log(2.0)
    return {
        'x_prompt': nrm(0, (BATCH, SEQ, D), 1.0),
        'x_sample': nrm(1, (DEC_BATCH, DEC_SEQ, D), 1.0),
        'cache_mla_ckv': nrm(2, (DEC_BATCH, L, PAST_LEN, MLA_KV_LORA), 1.0),
        'cache_mla_krope': nrm(3, (DEC_BATCH, L, PAST_LEN, MLA_ROPE), 1.0),
        'state_ret': nrm(4, (DEC_BATCH, L, 2, RET_HEADS, RET_DK, RET_DV), 0.5),
        'c': nrm(5, (DEC_BATCH, D), 1.0),
        'c_ctx': nrm(6, (D,), 1.0),
        'w_ada': nrm(7, (L, D, N_MOD * D), 0.5 * D ** -0.5),
        'b_ada': nrm(8, (L, N_MOD * D), 0.02),
        'norm_pre': 1.0 + nrm(9, (L, 3, D), 0.1),
        'norm_post': 1.0 + nrm(10, (L, 3, D), 0.1),
        'ffn1_w_gu': nrm(11, (L, D, 2 * D_FF), D ** -0.5),
        'ffn1_w_down': nrm(12, (L, D_FF, D), D_FF ** -0.5),
        'ffn2_w_gu': nrm(13, (L, D, 2 * D_FF), D ** -0.5),
        'ffn2_w_down': nrm(14, (L, D_FF, D), D_FF ** -0.5),
        'w_in': nrm(15, (L, D, IN_W), D ** -0.5),
        'mla_q_norm': 1.0 + nrm(16, (L, MLA_Q_LORA), 0.1),
        'mla_w_uq': nrm(17, (L, MLA_Q_LORA, MLA_HEADS * MLA_QK), MLA_Q_LORA ** -0.5),
        'mla_kv_norm': 1.0 + nrm(18, (L, MLA_KV_LORA), 0.1),
        'mla_w_ukv': nrm(19, (L, MLA_KV_LORA, MLA_HEADS * (MLA_NOPE + MLA_V)), MLA_KV_LORA ** -0.5),
        'ret_decay': ret_base + nrm(20, (L, 2, RET_HEADS), 0.05),
        'pool_w': nrm(21, (L, POOL_GROUPS, POOL_GROUP_W, POOL_GROUP_W), POOL_GROUP_W ** -0.5),
        'pool_scale': 1.0 + nrm(22, (L, POOL_W), 0.1),
        'w_branch_attn': nrm(23, (L, MLA_HEADS * MLA_V, D), (MLA_HEADS * MLA_V) ** -0.5),
        'w_branch_ret': nrm(24, (L, RET_HEADS * RET_DV, D), (RET_HEADS * RET_DV) ** -0.5),
        'w_branch_pool': nrm(25, (L, POOL_W, D), POOL_W ** -0.5),
        'w_out': nrm(26, (L, D, D), D ** -0.5),
    }


def reference(x_prompt, x_sample, cache_mla_ckv, cache_mla_krope, state_ret, c, c_ctx,
              w_ada, b_ada, norm_pre, norm_post, ffn1_w_gu, ffn1_w_down, ffn2_w_gu, ffn2_w_down,
              w_in, mla_q_norm, mla_w_uq, mla_kv_norm, mla_w_ukv, ret_decay, pool_w, pool_scale,
              w_branch_attn, w_branch_ret, w_branch_pool, w_out):
    x_ctx, x_lat = x_prompt, x_sample
    ckv_list, kr_list, st_list = [], [], []
    for l in range(DEPTH):
        lp = dict(w_ada=w_ada[l], b_ada=b_ada[l], norm_pre=norm_pre[l], norm_post=norm_post[l],
                  ffn1_w_gu=ffn1_w_gu[l], ffn1_w_down=ffn1_w_down[l],
                  ffn2_w_gu=ffn2_w_gu[l], ffn2_w_down=ffn2_w_down[l], w_in=w_in[l],
                  mla_q_norm=mla_q_norm[l], mla_w_uq=mla_w_uq[l], mla_kv_norm=mla_kv_norm[l],
                  mla_w_ukv=mla_w_ukv[l], ret_decay=ret_decay[l], pool_w=pool_w[l],
                  pool_scale=pool_scale[l], w_branch_attn=w_branch_attn[l],
                  w_branch_ret=w_branch_ret[l], w_branch_pool=w_branch_pool[l], w_out=w_out[l])
        x_ctx, (ckv_l, kr_l, st_l) = trunk_layer(x_ctx, c_ctx[None, :], lp,
                                                  functools.partial(mixer_context, lp=lp))
        ckv_list.append(ckv_l)
        kr_list.append(kr_l)
        st_list.append(st_l)
        x_lat, _ = trunk_layer(x_lat, c, lp,
                               functools.partial(mixer_latent, ckv_ctx=cache_mla_ckv[:, l],
                                                 kr_ctx=cache_mla_krope[:, l], st_ctx=state_ret[:, l], lp=lp))
    new_mla_ckv = jnp.stack(ckv_list, axis=1)
    new_mla_krope = jnp.stack(kr_list, axis=1)
    new_state_ret = jnp.stack(st_list, axis=1)
    return (x_ctx, x_lat, new_mla_ckv, new_mla_krope, new_state_ret)
```

```cpp
#include <hip/hip_runtime.h>
#include <hip/hip_cooperative_groups.h>
#include <cstdio>
#include <cstdint>
namespace cg = cooperative_groups;
namespace pg8 {
#define PG8_LAS __attribute__((address_space(3)))
typedef unsigned short bf16_t;
typedef short bf16x8 __attribute__((ext_vector_type(8)));
typedef float f32x4 __attribute__((ext_vector_type(4)));
typedef unsigned u32x4 __attribute__((ext_vector_type(4)));
constexpr int BM = 256, BK = 64, HALF = 128, HTB = HALF * BK * 2  , STAGE_BYTES = 8 * HTB, NXCD = 8, WGM = 8;

__host__ __device__ __forceinline__ int lds_byte(int r, int c) { const int st = (r >> 4) * 2 + (c >> 5), rr = r & 15, cc = c & 31, ob = rr * 64 + cc * 2; return st * 1024 + (ob ^ (((ob >> 9) & 1) << 5)); }
__host__ __device__ __forceinline__ void stage_rc(int b, int& R, int& C) { const int st = b / 1024, sb = b % 1024, swz = sb ^ (((sb >> 9) & 1) << 5); R = (st >> 1) * 16 + swz / 64; C = (st & 1) * 32 + (swz % 64) / 2; }
__host__ __device__ __forceinline__ int perm32(int rho) { const int n = rho >> 4, i = rho & 15; return 8 * (i >> 2) + 4 * n + (i & 3); }

struct Unit { int pm, pn; };
struct Gemm { const bf16_t* A; const bf16_t* Bt; int M, N, K; };

struct StaticOrder {
    int nM, nN, nwg, G, c;
    __host__ __device__ void init(int M, int N, int G_, int c_) { nM = M / BM; nN = N / BM; nwg = nM * nN; G = G_; c = c_; }
    __host__ __device__ bool next(int i, Unit& u) const {
        const long L = (long)i * G + c; if (L >= nwg) return false;
        int wgid = (int)L; { const int q = nwg / NXCD, r = nwg % NXCD, xcd = wgid % NXCD, off = wgid / NXCD; wgid = (xcd < r ? xcd * (q + 1) : r * (q + 1) + (xcd - r) * q) + off; }
        const int nig = WGM * nN, gid = wgid / nig, fm = gid * WGM, gsz = (nM - fm) < WGM ? (nM - fm) : WGM;
        u.pm = fm + ((wgid % nig) % gsz); u.pn = (wgid % nig) / gsz; return true;
    }
    __device__ __forceinline__ void a_ready(const Unit&) const {}
    __device__ __forceinline__ void done(const Unit&) const {}
};
__device__ __forceinline__ unsigned cvt_pk_bf16(float lo, float hi) { unsigned r; asm volatile("v_cvt_pk_bf16_f32 %0, %1, %2" : "=v"(r) : "v"(lo), "v"(hi)); return r; }
template <class Epi, class Sched, bool ALIGN_EPI = false, bool SP2 = false>
__device__ __forceinline__ void gemm_phase(PG8_LAS unsigned char* lds, const Gemm g, const Sched& S, const Epi& E) {
    int tid_ = threadIdx.x; asm volatile("" : "+v"(tid_)); const int tid = tid_, wid = __builtin_amdgcn_readfirstlane(tid >> 6), lane = tid & 63, wr = wid >> 2, wc = wid & 3, fr = lane & 15, fq = lane >> 4;
    const int K = g.K, nt = K / BK;
    unsigned voffA[2], voffB[2];
#pragma unroll
    for (int i = 0; i < 2; ++i) { int R, C; stage_rc(tid * 16 + i * 8192, R, C); const int Rb = Epi::PERM ? ((R & ~31) + perm32(R & 31)) : R;
        voffA[i] = (unsigned)(R * K + C) * 2u; voffB[i] = (unsigned)(Rb * K + C) * 2u; }
    const size_t kstep = (size_t)(BK * 2);
    const size_t hstep = (size_t)HALF * K * 2;
    const size_t tstep = 2 * hstep;
    const unsigned ldsw = (unsigned)wid * 1024u;
    const int aoff = lds_byte(wr * 64 + fr, fq * 8), boff = lds_byte(wc * 32 + fr, fq * 8);
#define PG8_SA(b, h) (((b) * 2 + (h)) * HTB)
#define PG8_SB(b, h) ((4 + (b) * 2 + (h)) * HTB)
#define PG8_STAGE(bufoff, gbase, voff) do { _Pragma("unroll") for (int _i = 0; _i < 2; ++_i) \
        __builtin_amdgcn_global_load_lds((const unsigned*)((const char*)(gbase) + (voff)[_i]), (PG8_LAS unsigned*)(lds + (bufoff) + ldsw + _i * 8192), 16, 0, 0); } while (0)
#define PG8_LDA(dst, b, h) do { _Pragma("unroll") for (int m = 0; m < 4; ++m) _Pragma("unroll") for (int k = 0; k < 2; ++k) dst[m][k] = *(const PG8_LAS bf16x8*)(lds + PG8_SA(b, h) + aoff + m * 2048 + k * 1024); } while (0)
#define PG8_LDB(dst, b, h) do { _Pragma("unroll") for (int n = 0; n < 2; ++n) _Pragma("unroll") for (int k = 0; k < 2; ++k) dst[n][k] = *(const PG8_LAS bf16x8*)(lds + PG8_SB(b, h) + boff + n * 2048 + k * 1024); } while (0)
#define PG8_MMA(ai, bj, At, Bt) do { __builtin_amdgcn_s_setprio(1); _Pragma("unroll") for (int m = 0; m < 4; ++m) _Pragma("unroll") for (int n = 0; n < 2; ++n) _Pragma("unroll") for (int k = 0; k < 2; ++k) \
        acc[ai][bj][m][n] = __builtin_amdgcn_mfma_f32_16x16x32_bf16(Bt[n][k], At[m][k], acc[ai][bj][m][n], 0, 0, 0); __builtin_amdgcn_s_setprio(0); } while (0)
#define PG8_WAIT_V(n) asm volatile("s_waitcnt vmcnt(" #n ")" ::: "memory")
#define PG8_WAIT_L(n) asm volatile("s_waitcnt lgkmcnt(" #n ")" ::: "memory")
#define PG8_BAR __builtin_amdgcn_s_barrier()
#define PG8_SCHED __builtin_amdgcn_sched_barrier(0)
    Unit cur, nxt; int ui = 0;
    if (!S.next(0, cur)) return;
    f32x4 acc[2][2][4][2];
#pragma unroll
    for (int a = 0; a < 2; ++a)
#pragma unroll
        for (int b = 0; b < 2; ++b)
#pragma unroll
            for (int m = 0; m < 4; ++m)
#pragma unroll
                for (int n = 0; n < 2; ++n) acc[a][b][m][n] = (f32x4){0.f, 0.f, 0.f, 0.f};
    bf16x8 At[4][2], B0[2][2], B1[2][2];
    const char* cA = (const char*)g.A + (size_t)cur.pm * tstep; const char* cB = (const char*)g.Bt + (size_t)cur.pn * tstep;
    S.a_ready(cur);
    if constexpr (SP2) {
        PG8_STAGE(PG8_SB(0, 0), cB, voffB); PG8_STAGE(PG8_SB(0, 1), cB + hstep, voffB); PG8_STAGE(PG8_SA(0, 0), cA, voffA); PG8_STAGE(PG8_SA(0, 1), cA + hstep, voffA);
        if (wr == 1) PG8_BAR;
        PG8_WAIT_V(2); PG8_BAR;
        PG8_STAGE(PG8_SB(1, 0), cB + kstep, voffB); PG8_STAGE(PG8_SA(1, 0), cA + kstep, voffA); PG8_STAGE(PG8_SB(1, 1), cB + hstep + kstep, voffB);
        PG8_WAIT_V(6); PG8_BAR;
    } else {
        PG8_STAGE(PG8_SB(0, 0), cB, voffB); PG8_STAGE(PG8_SA(0, 0), cA, voffA); PG8_STAGE(PG8_SB(0, 1), cB + hstep, voffB); PG8_STAGE(PG8_SA(0, 1), cA + hstep, voffA);
        if (wr == 1) PG8_BAR;
        PG8_WAIT_V(4); PG8_BAR;
        PG8_STAGE(PG8_SB(1, 0), cB + kstep, voffB); PG8_STAGE(PG8_SA(1, 0), cA + kstep, voffA); PG8_STAGE(PG8_SB(1, 1), cB + hstep + kstep, voffB);
        PG8_WAIT_V(6); PG8_BAR;
    }
    for (;;) {
        const bool has_next = S.next(ui + 1, nxt);
        const char* nA = has_next ? (const char*)g.A + (size_t)nxt.pm * tstep : cA; const char* nB = has_next ? (const char*)g.Bt + (size_t)nxt.pn * tstep : cB;
#pragma unroll 1
        for (int t = 0; t < nt; t += 2) {
            const bool last = (t == nt - 2);
            const char* a1 = cA + (size_t)(t + 1) * kstep;
            const char* a2 = last ? nA : cA + (size_t)(t + 2) * kstep; const char* b2 = last ? nB : cB + (size_t)(t + 2) * kstep;
            const char* a3 = a2 + kstep; const char* b3 = b2 + kstep;
            if (last && has_next) S.a_ready(nxt);
            if constexpr (SP2) {
            PG8_LDB(B0, 0, 0); PG8_LDB(B1, 0, 1); PG8_SCHED; PG8_LDA(At, 0, 0); PG8_STAGE(PG8_SA(1, 1), a1 + hstep, voffA);
            PG8_WAIT_V(8); PG8_WAIT_L(0); PG8_BAR; PG8_MMA(0, 0, At, B0); PG8_MMA(0, 1, At, B1); PG8_BAR; PG8_SCHED;
            PG8_LDA(At, 0, 1); PG8_STAGE(PG8_SB(0, 0), b2, voffB); PG8_STAGE(PG8_SB(0, 1), b2 + hstep, voffB); PG8_STAGE(PG8_SA(0, 0), a2, voffA);
            PG8_WAIT_V(8); PG8_WAIT_L(0); PG8_BAR; PG8_MMA(1, 0, At, B0); PG8_MMA(1, 1, At, B1); PG8_BAR; PG8_SCHED;
            PG8_LDB(B0, 1, 0); PG8_LDB(B1, 1, 1); PG8_SCHED; PG8_LDA(At, 1, 0); PG8_STAGE(PG8_SA(0, 1), a2 + hstep, voffA);
            PG8_WAIT_V(8); PG8_WAIT_L(0); PG8_BAR; PG8_MMA(0, 0, At, B0); PG8_MMA(0, 1, At, B1); PG8_BAR; PG8_SCHED;
            PG8_LDA(At, 1, 1); PG8_STAGE(PG8_SB(1, 0), b3, voffB); PG8_STAGE(PG8_SB(1, 1), b3 + hstep, voffB); PG8_STAGE(PG8_SA(1, 0), a3, voffA);
            PG8_WAIT_V(8); PG8_WAIT_L(0); PG8_BAR; PG8_MMA(1, 0, At, B0); PG8_MMA(1, 1, At, B1); PG8_BAR; PG8_SCHED;
            } else {
            PG8_LDB(B0, 0, 0); PG8_SCHED; PG8_LDA(At, 0, 0); PG8_STAGE(PG8_SA(1, 1), a1 + hstep, voffA);
            PG8_WAIT_L(8); PG8_BAR; PG8_WAIT_L(0); PG8_MMA(0, 0, At, B0); PG8_BAR; PG8_SCHED;
            PG8_LDB(B1, 0, 1); PG8_STAGE(PG8_SB(0, 0), b2, voffB);
            PG8_BAR; PG8_WAIT_L(0); PG8_MMA(0, 1, At, B1); PG8_BAR;
            PG8_LDA(At, 0, 1); PG8_STAGE(PG8_SA(0, 0), a2, voffA);
            PG8_BAR; PG8_WAIT_L(0); PG8_MMA(1, 0, At, B0); PG8_BAR; PG8_SCHED;
            PG8_STAGE(PG8_SB(0, 1), b2 + hstep, voffB);
            PG8_WAIT_V(6); PG8_BAR; PG8_MMA(1, 1, At, B1); PG8_BAR;
            PG8_LDB(B0, 1, 0); PG8_SCHED; PG8_LDA(At, 1, 0); PG8_STAGE(PG8_SA(0, 1), a2 + hstep, voffA);
            PG8_WAIT_L(8); PG8_BAR; PG8_WAIT_L(0); PG8_MMA(0, 0, At, B0); PG8_BAR; PG8_SCHED;
            PG8_LDB(B1, 1, 1); PG8_STAGE(PG8_SB(1, 0), b3, voffB);
            PG8_BAR; PG8_WAIT_L(0); PG8_MMA(0, 1, At, B1); PG8_BAR;
            PG8_LDA(At, 1, 1); PG8_STAGE(PG8_SA(1, 0), a3, voffA);
            PG8_BAR; PG8_WAIT_L(0); PG8_MMA(1, 0, At, B0); PG8_BAR; PG8_SCHED;
            PG8_STAGE(PG8_SB(1, 1), b3 + hstep, voffB);
            PG8_WAIT_V(6); PG8_BAR; PG8_MMA(1, 1, At, B1); PG8_BAR;
            }
        }
        if constexpr (ALIGN_EPI) { if (wr == 0) PG8_BAR; }
        if constexpr (!Epi::AFTER_DRAIN) { E(acc, cur, wr, wc, fr, fq); S.done(cur); }
        if (!has_next) break;
#pragma unroll
        for (int a = 0; a < 2; ++a)
#pragma unroll
            for (int b = 0; b < 2; ++b)
#pragma unroll
                for (int m = 0; m < 4; ++m)
#pragma unroll
                    for (int n = 0; n < 2; ++n) acc[a][b][m][n] = (f32x4){0.f, 0.f, 0.f, 0.f};
        cur = nxt; cA = nA; cB = nB; ++ui;
        if constexpr (ALIGN_EPI) { if (wr == 1) PG8_BAR; }
    }
    PG8_WAIT_V(0);
    if constexpr (!ALIGN_EPI) { if (wr == 0) PG8_BAR; }
    PG8_BAR;
    if constexpr (Epi::AFTER_DRAIN) { E.fused(acc, cur, wr, wc, fr, fq, lds, wid, lane); S.done(cur); }
#undef PG8_SA
#undef PG8_SB
#undef PG8_STAGE
#undef PG8_LDA
#undef PG8_LDB
#undef PG8_MMA
#undef PG8_WAIT_V
#undef PG8_WAIT_L
#undef PG8_BAR
#undef PG8_SCHED
}
}

#define LAS __attribute__((address_space(3)))
typedef unsigned short bf16;
using pg8::f32x4; using pg8::bf16x8; using pg8::u32x4; using pg8::Unit;
typedef unsigned u32x2 __attribute__((ext_vector_type(2)));
typedef float f32x2 __attribute__((ext_vector_type(2)));

constexpr int DM = 1024, MC = 4096, ML = 16384, MT = 20480, DFF = 2816;
constexpr float EPS = 1e-6f;
constexpr float LOG2E = 1.4426950408889634f;
constexpr float QSCALE = 0.10206207261596577f * 1.4426950408889634f;
constexpr size_t MiB = 1u << 20;
constexpr size_t WS_MOD = 0;
constexpr size_t WS_SSQ = 512 * 1024;
constexpr size_t WS_ROPE8 = 1 * MiB;
constexpr size_t WS_ROPE64 = 2 * MiB;
constexpr size_t WS_KVF32 = 4 * MiB;
constexpr size_t WS_CACHEA = 6 * MiB;
constexpr size_t WS_W = 7 * MiB;
constexpr size_t WS_H = 27 * MiB;
constexpr size_t WS_ACT = 67 * MiB;
constexpr size_t WS_YF = 177 * MiB;
constexpr size_t WS_QKC = 67 * MiB;
constexpr size_t WS_RGS = 87 * MiB;
constexpr size_t WS_YPOOL = 107 * MiB;
constexpr size_t WS_PU = 127 * MiB;
constexpr size_t WS_RQ = 147 * MiB, WS_RK = 167 * MiB, WS_RV = 187 * MiB;
constexpr size_t WS_Q = 207 * MiB;
constexpr size_t WS_K = 237 * MiB;
constexpr size_t WS_VT = 270 * MiB;
constexpr size_t WS_ULAT = 292 * MiB;
constexpr size_t WS_UCTX = 324 * MiB;
constexpr size_t WS_SCTX = 340 * MiB;
constexpr size_t WS_GF = 127 * MiB, WS_BF = 167 * MiB, WS_SG = 287 * MiB;
constexpr size_t WS_BF2 = 247 * MiB;
constexpr size_t WS_GATE = 127 * MiB;
constexpr size_t WS_YM = 247 * MiB;
constexpr size_t WS_YO = 127 * MiB;
constexpr size_t WS_END = 348 * MiB;
constexpr size_t WA_GU = 0, WA_D = 12 * MiB;
constexpr size_t WA_INB = 0, WA_ING = 6 * MiB, WA_UQ = 12 * MiB, WA_KF = 12 * MiB + 512 * 1024, WA_KP = 12 * MiB + 768 * 1024,
                 WA_VF = 13 * MiB, WA_VP = 13 * MiB + 256 * 1024, WA_BA = 14 * MiB, WA_BR = 15 * MiB, WA_EFF = 16 * MiB, WA_OUT = 18 * MiB;
constexpr size_t K_CTX_ROWS = 16 * 8 * 256, V_CTX_ROWS = 16 * 8 * 64;
constexpr int OUT_CKV = MT * DM, OUT_KR = OUT_CKV + 16 * 2 * 256 * 128, OUT_ST = OUT_KR + 16 * 2 * 256 * 32;

struct Params {
    const float *x_prompt, *x_sample, *cache_ckv, *cache_kr, *state_ret, *c, *c_ctx, *w_ada, *b_ada, *norm_pre, *norm_post,
        *ffn1_gu, *ffn1_d, *ffn2_gu, *ffn2_d, *w_in, *q_norm, *w_uq, *kv_norm, *w_ukv, *ret_decay, *pool_w, *pool_scale, *w_ba, *w_br, *w_bp, *w_out;
    float* out; unsigned char* ws;
};

__device__ __forceinline__ unsigned pk(float lo, float hi) { return pg8::cvt_pk_bf16(lo, hi); }
__device__ __forceinline__ float bf2f(unsigned short b) { return __uint_as_float((unsigned)b << 16); }
__device__ __forceinline__ float bflo(unsigned w) { return __uint_as_float(w << 16); }
__device__ __forceinline__ float bfhi(unsigned w) { return __uint_as_float(w & 0xffff0000u); }
__device__ __forceinline__ u32x4 pack8(const f32x4 a, const f32x4 b) { u32x4 w; w.x = pk(a[0], a[1]); w.y = pk(a[2], a[3]); w.z = pk(b[0], b[1]); w.w = pk(b[2], b[3]); return w; }
__device__ __forceinline__ float fast_exp2(float x) { return __builtin_amdgcn_exp2f(x); }
__device__ __forceinline__ float sigmoidf_(float x) { return __builtin_amdgcn_rcpf(1.0f + fast_exp2(-x * LOG2E)); }
__device__ __forceinline__ float siluf_(float x) { return x * sigmoidf_(x); }
__device__ __forceinline__ float wave_sum(float v) {
#pragma unroll
    for (int o = 1; o < 64; o <<= 1) v += __shfl_xor(v, o);
    return v;
}
__device__ __forceinline__ f32x4 rope4(const f32x4 v, const float2 a, const float2 b) {
    f32x4 o; o[0] = v[0] * a.x - v[1] * a.y; o[1] = v[0] * a.y + v[1] * a.x; o[2] = v[2] * b.x - v[3] * b.y; o[3] = v[2] * b.y + v[3] * b.x; return o;
}

#define EPI_ROW(u, ai, m) ((u).pm * 256 + (ai) * 128 + wr * 64 + (m) * 16 + fr)
#define EPI_COL(bj) ((bj) * 128 + wc * 32 + 8 * fq)

struct EpiGU {
    static constexpr bool PERM = true, AFTER_DRAIN = false;
    bf16* act;
    __device__ __forceinline__ void operator()(const f32x4 (&acc)[2][2][4][2], const Unit& u, int wr, int wc, int fr, int fq) const {
#pragma unroll
        for (int ai = 0; ai < 2; ++ai)
#pragma unroll
            for (int m = 0; m < 4; ++m) {
                const int row = EPI_ROW(u, ai, m);
                f32x4 o0, o1;
#pragma unroll
                for (int i = 0; i < 4; ++i) { o0[i] = siluf_(acc[ai][0][m][0][i]) * acc[ai][1][m][0][i]; o1[i] = siluf_(acc[ai][0][m][1][i]) * acc[ai][1][m][1][i]; }
                *(u32x4*)(act + (size_t)row * DFF + u.pn * 128 + wc * 32 + 8 * fq) = pack8(o0, o1);
            }
    }
};
struct EpiF32 {
    static constexpr bool PERM = true, AFTER_DRAIN = false;
    float* out; int ld;
    __device__ __forceinline__ void operator()(const f32x4 (&acc)[2][2][4][2], const Unit& u, int wr, int wc, int fr, int fq) const {
#pragma unroll
        for (int ai = 0; ai < 2; ++ai)
#pragma unroll
            for (int m = 0; m < 4; ++m) {
                float* rp = out + (size_t)EPI_ROW(u, ai, m) * ld + u.pn * 256;
#pragma unroll
                for (int bj = 0; bj < 2; ++bj) { *(f32x4*)(rp + EPI_COL(bj)) = acc[ai][bj][m][0]; *(f32x4*)(rp + EPI_COL(bj) + 4) = acc[ai][bj][m][1]; }
            }
    }
};
struct EpiBf16 {
    static constexpr bool PERM = true, AFTER_DRAIN = false;
    bf16* out; int ld;
    __device__ __forceinline__ void operator()(const f32x4 (&acc)[2][2][4][2], const Unit& u, int wr, int wc, int fr, int fq) const {
        asm volatile("" : "+v"(fr), "+v"(fq));
#pragma unroll
        for (int ai = 0; ai < 2; ++ai)
#pragma unroll
            for (int m = 0; m < 4; ++m) {
                bf16* rp = out + (size_t)EPI_ROW(u, ai, m) * ld + u.pn * 256;
#pragma unroll
                for (int bj = 0; bj < 2; ++bj) *(u32x4*)(rp + EPI_COL(bj)) = pack8(acc[ai][bj][m][0], acc[ai][bj][m][1]);
                asm volatile("" ::: "memory");
            }
    }
};
struct EpiGate {
    static constexpr bool PERM = true, AFTER_DRAIN = false;
    bf16* out;
    __device__ __forceinline__ void operator()(const f32x4 (&acc)[2][2][4][2], const Unit& u, int wr, int wc, int fr, int fq) const {
#pragma unroll
        for (int ai = 0; ai < 2; ++ai)
#pragma unroll
            for (int m = 0; m < 4; ++m) {
                bf16* rp = out + (size_t)EPI_ROW(u, ai, m) * DM + u.pn * 256;
#pragma unroll
                for (int bj = 0; bj < 2; ++bj) { f32x4 a = acc[ai][bj][m][0], b = acc[ai][bj][m][1];
#pragma unroll
                    for (int i = 0; i < 4; ++i) { a[i] = sigmoidf_(a[i]); b[i] = sigmoidf_(b[i]); }
                    *(u32x4*)(rp + EPI_COL(bj)) = pack8(a, b); }
            }
    }
};
template <int MODE> struct EpiMerge {
    static constexpr bool PERM = true, AFTER_DRAIN = false;
    bf16* gate; float* ym; bf16* outb;
    __device__ __forceinline__ void operator()(const f32x4 (&acc)[2][2][4][2], const Unit& u, int wr, int wc, int fr, int fq) const {
#pragma unroll
        for (int ai = 0; ai < 2; ++ai)
#pragma unroll
            for (int m = 0; m < 4; ++m) {
                const size_t ro = (size_t)EPI_ROW(u, ai, m) * DM + u.pn * 256;
#pragma unroll
                for (int bj = 0; bj < 2; ++bj) {
                    const u32x4 g = *(const u32x4*)(gate + ro + EPI_COL(bj));
                    f32x4 a = acc[ai][bj][m][0], b = acc[ai][bj][m][1];
                    a[0] *= bflo(g.x); a[1] *= bfhi(g.x); a[2] *= bflo(g.y); a[3] *= bfhi(g.y);
                    b[0] *= bflo(g.z); b[1] *= bfhi(g.z); b[2] *= bflo(g.w); b[3] *= bfhi(g.w);
                    float* yp = ym + ro + EPI_COL(bj);
                    if (MODE >= 1) { a += *(const f32x4*)yp; b += *(const f32x4*)(yp + 4); }
                    if (MODE <= 1) { *(f32x4*)yp = a; *(f32x4*)(yp + 4) = b; }
                    else *(u32x4*)(outb + ro + EPI_COL(bj)) = pack8(a, b);
                }
            }
    }
};

struct EpiWinB {
    static constexpr bool PERM = true, AFTER_DRAIN = false;
    unsigned char* ws; float* out; int layer;
    __device__ __forceinline__ void operator()(const f32x4 (&acc)[2][2][4][2], const Unit& u, int wr, int wc, int fr, int fq) const {
        int t = u.pn; asm volatile("" : "+s"(t)); const bool lat = u.pm >= 16;
        asm volatile("" : "+v"(fr), "+v"(fq));
        bf16* const qkc = (bf16*)(ws + WS_QKC); bf16* const Kctx = (bf16*)(ws + WS_K); bf16* const Klat = Kctx + K_CTX_ROWS * 96;
        float* const ssq_q = (float*)(ws + WS_SSQ) + (size_t)layer * 2 * MT; float* const ssq_kv = ssq_q + MT; float* const kvf32 = (float*)(ws + WS_KVF32); float* const out_kr = out + OUT_KR;
        const float2* const rope64 = (const float2*)(ws + WS_ROPE64); const float2* const rope8 = (const float2*)(ws + WS_ROPE8);
        if (t == 0) {
#pragma unroll
            for (int ai = 0; ai < 2; ++ai)
#pragma unroll
                for (int m = 0; m < 4; ++m) {
                    const int row = EPI_ROW(u, ai, m); float ss = 0.f;
#pragma unroll
                    for (int bj = 0; bj < 2; ++bj) { const f32x4 a = acc[ai][bj][m][0], b = acc[ai][bj][m][1];
                        ss += (a[0] * a[0] + a[1] * a[1]) + (a[2] * a[2] + a[3] * a[3]) + (b[0] * b[0] + b[1] * b[1]) + (b[2] * b[2] + b[3] * b[3]);
                        *(u32x4*)(qkc + (size_t)row * 256 + EPI_COL(bj)) = pack8(a, b); }
                    ss += __shfl_xor(ss, 16); ss += __shfl_xor(ss, 32);
                    if (fq == 0) atomicAdd(ssq_q + row, ss);
                    asm volatile("" ::: "memory");
                }
        } else if (t == 1) {
#pragma unroll
            for (int ai = 0; ai < 2; ++ai)
#pragma unroll
                for (int m = 0; m < 4; ++m) {
                    const int row = EPI_ROW(u, ai, m);
                    bf16* kvc = qkc + (size_t)MT * 256 + (size_t)row * 256;
                    { const f32x4 a = acc[ai][0][m][0], b = acc[ai][0][m][1];
                      float ss = (a[0] * a[0] + a[1] * a[1]) + (a[2] * a[2] + a[3] * a[3]) + (b[0] * b[0] + b[1] * b[1]) + (b[2] * b[2] + b[3] * b[3]);
                      *(u32x4*)(kvc + EPI_COL(0)) = pack8(a, b);
                      if (!lat) { float* kf = kvf32 + (size_t)row * 128 + wc * 32 + 8 * fq; *(f32x4*)kf = a; *(f32x4*)(kf + 4) = b; }
                      ss += __shfl_xor(ss, 16); ss += __shfl_xor(ss, 32);
                      if (fq == 0) atomicAdd(ssq_kv + row, ss); }
                    f32x4 a = acc[ai][1][m][0], b = acc[ai][1][m][1];
                    *(u32x4*)(kvc + EPI_COL(1)) = pack8(a, b);
                    if (wc == 0) {
                        const int part = fq >> 1, jb = (fq & 1) * 4;
                        if (lat) {
                            const int ml = row - MC, tt = ml & 4095, pos = part == 0 ? (tt >> 6) : (tt & 63);
                            const float2* cs = rope8 + pos * 8 + jb;
                            a = rope4(a, cs[0], cs[1]); b = rope4(b, cs[2], cs[3]);
                            const u32x4 w = pack8(a, b);
                            bf16* kp = Klat + ((size_t)((ml >> 12) * 8) * 4608 + (ml & 4095)) * 96 + 64 + 8 * fq;
#pragma unroll
                            for (int h = 0; h < 8; ++h) *(u32x4*)(kp + (size_t)h * 4608 * 96) = w;
                        } else {
                            const u32x4 w = pack8(a, b);
                            bf16* kp = Kctx + ((size_t)((row >> 8) * 8) * 256 + (row & 255)) * 96 + 64 + 8 * fq;
#pragma unroll
                            for (int h = 0; h < 8; ++h) *(u32x4*)(kp + (size_t)h * 256 * 96) = w;
                            float* op = out_kr + ((size_t)((row >> 8) * 2 + layer) * 256 + (row & 255)) * 32 + 16 * part + jb;
                            *(f32x4*)op = (f32x4){a[0], a[2], b[0], b[2]}; *(f32x4*)(op + 8) = (f32x4){a[1], a[3], b[1], b[3]};
                        }
                    }
                    asm volatile("" ::: "memory");
                }
        } else if (t < 6) {
            bf16* dst = (bf16*)(ws + (t < 4 ? WS_RQ : WS_RK)); const float sc = t < 4 ? 1.0f : 0.08838834764831845f;
            const int i0 = 16 * wc + 4 * fq;
#pragma unroll
            for (int ai = 0; ai < 2; ++ai)
#pragma unroll
                for (int m = 0; m < 4; ++m) {
                    const int row = EPI_ROW(u, ai, m);
                    const float2* cs = rope64 + (size_t)((row - MC) & 4095) * 64 + i0;
#pragma unroll
                    for (int bj = 0; bj < 2; ++bj) {
                        f32x4 a = acc[ai][bj][m][0] * sc, b = acc[ai][bj][m][1] * sc;
                        if (lat) { a = rope4(a, cs[0], cs[1]); b = rope4(b, cs[2], cs[3]); }
                        *(u32x4*)(dst + (size_t)row * 512 + (t & 1) * 256 + EPI_COL(bj)) = pack8(a, b);
                    }
                    asm volatile("" ::: "memory");
                }
        } else {
            bf16* dst = (bf16*)(ws + (t < 8 ? WS_RV : (t < 10 ? WS_RGS : WS_PU)));
#pragma unroll
            for (int ai = 0; ai < 2; ++ai)
#pragma unroll
                for (int m = 0; m < 4; ++m) {
                    const int row = EPI_ROW(u, ai, m);
#pragma unroll
                    for (int bj = 0; bj < 2; ++bj) {
                        f32x4 a = acc[ai][bj][m][0], b = acc[ai][bj][m][1];
                        if (t == 8 || t == 9) {
#pragma unroll
                            for (int i = 0; i < 4; ++i) { a[i] = siluf_(a[i]); b[i] = siluf_(b[i]); } }
                        *(u32x4*)(dst + (size_t)row * 512 + (t & 1) * 256 + EPI_COL(bj)) = pack8(a, b);
                    }
                    asm volatile("" ::: "memory");
                }
        }
    }
};

struct EpiQ {
    static constexpr bool PERM = true, AFTER_DRAIN = false;
    bf16* Q; const float* ssq; const float2* rope8;
    __device__ __forceinline__ void operator()(const f32x4 (&acc)[2][2][4][2], const Unit& u, int wr, int wc, int fr, int fq) const {
        const bool lat = u.pm >= 16;
#pragma unroll
        for (int ai = 0; ai < 2; ++ai)
#pragma unroll
            for (int m = 0; m < 4; ++m) {
                const int row = EPI_ROW(u, ai, m);
                const float rs = rsqrtf(ssq[row] * (1.0f / 256.0f) + EPS) * QSCALE;
                const int tt = (row - MC) & 4095;
#pragma unroll
                for (int bj = 0; bj < 2; ++bj) {
                    const int gb = u.pn * 256 + bj * 128 + wc * 32;
                    f32x4 a = acc[ai][bj][m][0] * rs, b = acc[ai][bj][m][1] * rs;
                    if (lat && (gb % 96) == 64) {
                        const int part = fq >> 1, jb = (fq & 1) * 4, pos = part == 0 ? (tt >> 6) : (tt & 63);
                        const float2* cs = rope8 + pos * 8 + jb;
                        a = rope4(a, cs[0], cs[1]); b = rope4(b, cs[2], cs[3]);
                    }
                    *(u32x4*)(Q + (size_t)row * 768 + gb + 8 * fq) = pack8(a, b);
                }
                asm volatile("" ::: "memory");
            }
    }
};
struct EpiK {
    static constexpr bool PERM = true, AFTER_DRAIN = false;
    bf16 *Kctx, *Klat; const float* ssq; int cache;
    __device__ __forceinline__ void operator()(const f32x4 (&acc)[2][2][4][2], const Unit& u, int wr, int wc, int fr, int fq) const {
#pragma unroll
        for (int ai = 0; ai < 2; ++ai)
#pragma unroll
            for (int m = 0; m < 4; ++m) {
                const int row = EPI_ROW(u, ai, m);
                float rs = 1.0f; bf16* base; size_t nk, kb, key;
                if (cache) { base = Klat; nk = 4608; kb = row >> 9; key = 4096 + (row & 511); }
                else { rs = rsqrtf(ssq[row] * (1.0f / 128.0f) + EPS);
                    if (row < MC) { base = Kctx; nk = 256; kb = row >> 8; key = row & 255; }
                    else { base = Klat; nk = 4608; kb = (row - MC) >> 12; key = (row - MC) & 4095; } }
#pragma unroll
                for (int bj = 0; bj < 2; ++bj) {
                    const int c = u.pn * 256 + EPI_COL(bj), h = c >> 6, d = c & 63;
                    *(u32x4*)(base + ((kb * 8 + h) * nk + key) * 96 + d) = pack8(acc[ai][bj][m][0] * rs, acc[ai][bj][m][1] * rs);
                }
                asm volatile("" ::: "memory");
            }
    }
};
struct EpiVt {
    static constexpr bool PERM = true, AFTER_DRAIN = false;
    bf16 *Vctx, *Vlat; const float* ssq; int cache;
    __device__ __forceinline__ void operator()(const f32x4 (&acc)[2][2][4][2], const Unit& u, int wr, int wc, int fr, int fq) const {
#pragma unroll
        for (int bj = 0; bj < 2; ++bj) {
            const int tok = u.pn * 256 + EPI_COL(bj);
            f32x4 r0 = {1.f, 1.f, 1.f, 1.f}, r1 = r0; bf16* base; size_t nk, kb, key;
            if (cache) { base = Vlat; nk = 4608; kb = tok >> 9; key = 4096 + (tok & 511); }
            else { const f32x4 s0 = *(const f32x4*)(ssq + tok), s1 = *(const f32x4*)(ssq + tok + 4);
#pragma unroll
                for (int i = 0; i < 4; ++i) { r0[i] = rsqrtf(s0[i] * (1.0f / 128.0f) + EPS); r1[i] = rsqrtf(s1[i] * (1.0f / 128.0f) + EPS); }
                if (tok < MC) { base = Vctx; nk = 256; kb = tok >> 8; key = tok & 255; }
                else { base = Vlat; nk = 4608; kb = (tok - MC) >> 12; key = (tok - MC) & 4095; } }
#pragma unroll
            for (int ai = 0; ai < 2; ++ai)
#pragma unroll
                for (int m = 0; m < 4; ++m) {
                    const int f = EPI_ROW(u, ai, m), h = f >> 6, e = f & 63;
                    *(u32x4*)(base + ((kb * 8 + h) * 64 + e) * nk + key) = pack8(acc[ai][bj][m][0] * r0, acc[ai][bj][m][1] * r1);
                    asm volatile("" ::: "memory");
                }
        }
    }
};

__device__ __forceinline__ int kr_logical(int c) { return (c & 16) + ((c & 1) << 3) + ((c & 15) >> 1); }
__device__ __forceinline__ int src_col(int kind, int n) {
    switch (kind) {
    case 1: { const int pn = n >> 8, r = n & 255; return r < 128 ? pn * 128 + r : DFF + pn * 128 + (r - 128); }
    case 2: { const int t = n >> 8, r = n & 255;
        if (t == 0) return 3072 + r;
        if (t == 1) { if (r < 128) return 3328 + r; if (r < 160) return 3456 + kr_logical(r - 128); return -1; }
        if (t < 6) { const int base = t < 4 ? 3488 : 4000, head = ((t & 1) << 1) + (r >> 7), p = r & 127; return base + head * 128 + (p >> 1) + ((p & 1) << 6); }
        return 2976 + n; }
    case 4: { const int head = n / 96, cw = n - head * 96; return cw < 64 ? n : head * 96 + 64 + kr_logical(cw - 64); }
    case 5: return (n >> 6) * 128 + (n & 63);
    case 6: return (n >> 6) * 128 + 64 + (n & 63);
    default: return n;
    }
}
__device__ __forceinline__ void conv_job(const float* W, int Ksrc, int Nsrc, bf16* dst, int Kdst, int Nd, int kind, const float* gain, LAS float* scr, int gw, int ngw, int lane) {
    const int nblk = Nd >> 5, items = (Kdst >> 6) * nblk;
    const bool vec = (kind == 0 || kind == 1 || kind == 5 || kind == 6) && ((Nsrc & 3) == 0);
    for (int it = gw; it < items; it += ngw) {
        const int kb = it / nblk, nb = it - kb * nblk, k0 = kb << 6, n0 = nb << 5;
        if (vec) {
            const int n4 = (lane & 7) * 4, sc = src_col(kind, n0 + n4);
#pragma unroll
            for (int i = 0; i < 8; ++i) { const int kk = 8 * i + (lane >> 3), k = k0 + kk; f32x4 v = {0.f, 0.f, 0.f, 0.f};
                if (k < Ksrc) { v = __builtin_nontemporal_load((const f32x4*)(W + (size_t)k * Nsrc + sc)); if (gain) v *= gain[k]; }
                scr[kk * 33 + n4] = v[0]; scr[kk * 33 + n4 + 1] = v[1]; scr[kk * 33 + n4 + 2] = v[2]; scr[kk * 33 + n4 + 3] = v[3]; }
        } else {
            const int sc = src_col(kind, n0 + (lane & 31));
#pragma unroll 8
            for (int i = 0; i < 32; ++i) { const int kk = 2 * i + (lane >> 5), k = k0 + kk; float v = 0.f;
                if (sc >= 0 && k < Ksrc) { v = __builtin_nontemporal_load(W + (size_t)k * Nsrc + sc); if (gain) v *= gain[k]; }
                scr[kk * 33 + (lane & 31)] = v; }
        }
        asm volatile("s_waitcnt lgkmcnt(0)" ::: "memory");
        const int c = lane & 7;
#pragma unroll
        for (int j = 0; j < 4; ++j) { const int n = (lane >> 3) + 8 * j; const LAS float* s = scr + (8 * c) * 33 + n;
            u32x4 o; o.x = pk(s[0], s[33]); o.y = pk(s[66], s[99]); o.z = pk(s[132], s[165]); o.w = pk(s[198], s[231]);
            *(u32x4*)(dst + (size_t)(n0 + n) * Kdst + k0 + 8 * c) = o; }
        asm volatile("s_waitcnt lgkmcnt(0)" ::: "memory");
    }
}
__device__ __forceinline__ void conv_ffn(const float* gu, const float* dn, unsigned char* ws, LAS float* scr, int gw, int ngw, int lane) {
    conv_job(gu, DM, 2 * DFF, (bf16*)(ws + WS_W + WA_GU), DM, 2 * DFF, 1, nullptr, scr, gw, ngw, lane);
    conv_job(dn, DFF, DM, (bf16*)(ws + WS_W + WA_D), DFF, DM, 0, nullptr, scr, gw, ngw, lane);
}
__device__ __forceinline__ void conv_win(const Params& P, unsigned char* ws, int l, LAS float* scr, int gw, int ngw, int lane) {
    unsigned char* wa = ws + WS_W; const float* win = P.w_in + (size_t)l * DM * 6048;
    conv_job(win, DM, 6048, (bf16*)(wa + WA_INB), DM, 3072, 2, nullptr, scr, gw, ngw, lane);
    conv_job(win, DM, 6048, (bf16*)(wa + WA_ING), DM, 3072, 0, nullptr, scr, gw, ngw, lane);
}
__device__ __forceinline__ void conv_mixer(const Params& P, unsigned char* ws, int l, LAS float* scr, int gw, int ngw, int lane, int gtid, int gthreads) {
    unsigned char* wa = ws + WS_W;
    conv_job(P.w_uq + (size_t)l * 256 * 768, 256, 768, (bf16*)(wa + WA_UQ), 256, 768, 4, P.q_norm + l * 256, scr, gw, ngw, lane);
    const float* wukv = P.w_ukv + (size_t)l * 128 * 1024;
    conv_job(wukv, 128, 1024, (bf16*)(wa + WA_KF), 256, 512, 5, P.kv_norm + l * 128, scr, gw, ngw, lane);
    conv_job(wukv, 128, 1024, (bf16*)(wa + WA_KP), 256, 512, 5, nullptr, scr, gw, ngw, lane);
    conv_job(wukv, 128, 1024, (bf16*)(wa + WA_VF), 256, 512, 6, P.kv_norm + l * 128, scr, gw, ngw, lane);
    conv_job(wukv, 128, 1024, (bf16*)(wa + WA_VP), 256, 512, 6, nullptr, scr, gw, ngw, lane);
    conv_job(P.w_ba + (size_t)l * 512 * DM, 512, DM, (bf16*)(wa + WA_BA), 512, DM, 0, nullptr, scr, gw, ngw, lane);
    conv_job(P.w_br + (size_t)l * 512 * DM, 512, DM, (bf16*)(wa + WA_BR), 512, DM, 0, nullptr, scr, gw, ngw, lane);
    conv_job(P.w_out + (size_t)l * DM * DM, DM, DM, (bf16*)(wa + WA_OUT), DM, DM, 0, nullptr, scr, gw, ngw, lane);
    const float* pw = P.pool_w + (size_t)l * 4 * 128 * 128; const float* ps = P.pool_scale + l * 512; const float* wp = P.w_bp + (size_t)l * 512 * DM;
    bf16* weff = (bf16*)(wa + WA_EFF);
    for (int it = gtid; it < DM * 64; it += gthreads) {
        const int n = it & 1023, k8 = (it >> 10) * 8, g = k8 >> 7;
        float a[8] = {0.f, 0.f, 0.f, 0.f, 0.f, 0.f, 0.f, 0.f};
#pragma unroll 8
        for (int d = 0; d < 128; ++d) { const float w = ps[g * 128 + d] * wp[(size_t)(g * 128 + d) * DM + n];
#pragma unroll
            for (int j = 0; j < 8; ++j) a[j] += pw[(size_t)(k8 + j) * 128 + d] * w; }
        u32x4 o; o.x = pk(a[0], a[1]); o.y = pk(a[2], a[3]); o.z = pk(a[4], a[5]); o.w = pk(a[6], a[7]);
        *(u32x4*)(weff + (size_t)n * 512 + k8) = o;
    }
    bf16* ca = (bf16*)(ws + WS_CACHEA);
    for (int it = gtid; it < 2048 * 32; it += gthreads) {
        const int j = it >> 5, k8 = (it & 31) * 8; u32x4 o = {0u, 0u, 0u, 0u};
        if (k8 < 128) { const float* s = P.cache_ckv + ((size_t)((j >> 9) * 2 + l) * 512 + (j & 511)) * 128 + k8; const f32x4 a = *(const f32x4*)s, b = *(const f32x4*)(s + 4); o = pack8(a, b); }
        *(u32x4*)(ca + (size_t)j * 256 + k8) = o;
    }
}

__device__ __forceinline__ void mod_phase(const Params& P, unsigned char* ws, LAS float* lds, int tid, int wave, int lane) {
    LAS float* sc = lds; LAS float* red = lds + 5 * 1024;
    for (int i = tid; i < 5 * 1024; i += 512) { const int g = i >> 10, k = i & 1023; const float v = g == 0 ? P.c_ctx[k] : P.c[(g - 1) * 1024 + k]; sc[i] = v / (1.0f + expf(-v)); }
    __syncthreads();
    float* mod = (float*)(ws + WS_MOD);
    for (int item = blockIdx.x; item < 288; item += gridDim.x) {
        const int l = item / 144, cb = item - l * 144;
        const float* Wp = P.w_ada + (size_t)l * DM * 9216 + cb * 64 + lane;
        float a0 = 0.f, a1 = 0.f, a2 = 0.f, a3 = 0.f, a4 = 0.f;
#pragma unroll 8
        for (int k = wave * 128; k < wave * 128 + 128; ++k) { const float w = Wp[(size_t)k * 9216];
            a0 += sc[k] * w; a1 += sc[1024 + k] * w; a2 += sc[2048 + k] * w; a3 += sc[3072 + k] * w; a4 += sc[4096 + k] * w; }
        red[(wave * 5 + 0) * 64 + lane] = a0; red[(wave * 5 + 1) * 64 + lane] = a1; red[(wave * 5 + 2) * 64 + lane] = a2; red[(wave * 5 + 3) * 64 + lane] = a3; red[(wave * 5 + 4) * 64 + lane] = a4;
        __syncthreads();
        if (tid < 320) { const int g = tid >> 6, ln = tid & 63; float s = P.b_ada[l * 9216 + cb * 64 + ln];
#pragma unroll
            for (int w = 0; w < 8; ++w) s += red[(w * 5 + g) * 64 + ln];
            mod[(size_t)(l * 5 + g) * 9216 + cb * 64 + ln] = s; }
        __syncthreads();
    }
}
__device__ __forceinline__ void tables_phase(const Params& P, unsigned char* ws, int gtid, int gthreads) {
    float2* r64 = (float2*)(ws + WS_ROPE64); float2* r8 = (float2*)(ws + WS_ROPE8); float* ssq = (float*)(ws + WS_SSQ);
    for (int i = gtid; i < 4096 * 64; i += gthreads) { const int t = i >> 6, f = i & 63; const float inv = powf(10000.0f, -(float)f / 64.0f); const float ang = (float)t * inv; r64[i] = make_float2(cosf(ang), sinf(ang)); }
    for (int i = gtid; i < 64 * 8; i += gthreads) { const int t = i >> 3, f = i & 7; const float inv = powf(10000.0f, -(float)f / 8.0f); const float ang = (float)t * inv; r8[i] = make_float2(cosf(ang), sinf(ang)); }
    for (int i = gtid; i < 4 * MT; i += gthreads) ssq[i] = 0.f;
}

__device__ __forceinline__ void row_phase(const Params& P, unsigned char* ws, int mode, const bf16* y, int l_u, int s_u, float coef, int l_h, int s_h, bool x_in, int gw, int ngw, int lane) {
    const float* mod = (const float*)(ws + WS_MOD); bf16* H = (bf16*)(ws + WS_H);
    const int rp = (MT + ngw - 1) / ngw, r0 = gw * rp, r1 = min(r0 + rp, MT);
    if (r0 >= r1) return;
    const int lo = lane * 4;
#define ROW_XS(m) (x_in ? ((m) < MC ? P.x_prompt + (size_t)(m) * DM : P.x_sample + (size_t)((m) - MC) * DM) : P.out + (size_t)(m) * DM)
    f32x4 xn[4]; u32x2 yn[4];
    { const float* xs = ROW_XS(r0);
#pragma unroll
      for (int j = 0; j < 4; ++j) { xn[j] = *(const f32x4*)(xs + lo + 256 * j); yn[j] = mode != 0 ? __builtin_nontemporal_load((const u32x2*)(y + (size_t)r0 * DM + lo + 256 * j)) : (u32x2){0u, 0u}; } }
    f32x4 gt[4], po[4], sh[4], sc[4], pr[4]; int gprev = -1;
#pragma unroll
    for (int j = 0; j < 4; ++j) { gt[j] = (f32x4){0.f, 0.f, 0.f, 0.f}; po[j] = gt[j]; sh[j] = gt[j]; sc[j] = gt[j]; pr[j] = gt[j]; }
    for (int m = r0; m < r1; ++m) {
        const int g = m >> 12;
        f32x4 xv[4], yv[4];
#pragma unroll
        for (int j = 0; j < 4; ++j) { xv[j] = xn[j]; yv[j] = (f32x4){bflo(yn[j].x), bfhi(yn[j].x), bflo(yn[j].y), bfhi(yn[j].y)}; }
        if (m + 1 < r1) { const float* xs = ROW_XS(m + 1);
#pragma unroll
            for (int j = 0; j < 4; ++j) { xn[j] = *(const f32x4*)(xs + lo + 256 * j); if (mode != 0) yn[j] = __builtin_nontemporal_load((const u32x2*)(y + (size_t)(m + 1) * DM + lo + 256 * j)); } }
        if (g != gprev) { gprev = g;
        if (mode != 0) { const float* gp = mod + (size_t)(l_u * 5 + g) * 9216 + (3 * s_u + 2) * DM; const float* pp = P.norm_post + (l_u * 3 + s_u) * DM;
#pragma unroll
            for (int j = 0; j < 4; ++j) { gt[j] = *(const f32x4*)(gp + lo + 256 * j); po[j] = *(const f32x4*)(pp + lo + 256 * j); } }
        if (mode != 2) { const float* shp = mod + (size_t)(l_h * 5 + g) * 9216 + (3 * s_h) * DM; const float* scp = shp + DM; const float* pp = P.norm_pre + (l_h * 3 + s_h) * DM;
#pragma unroll
            for (int j = 0; j < 4; ++j) { sh[j] = *(const f32x4*)(shp + lo + 256 * j); sc[j] = *(const f32x4*)(scp + lo + 256 * j); pr[j] = *(const f32x4*)(pp + lo + 256 * j); } }
        }
        if (mode != 0) {
            float ss = 0.f;
#pragma unroll
            for (int j = 0; j < 4; ++j) ss += (yv[j][0] * yv[j][0] + yv[j][1] * yv[j][1]) + (yv[j][2] * yv[j][2] + yv[j][3] * yv[j][3]);
            const float rs = rsqrtf(wave_sum(ss) * (1.0f / DM) + EPS) * coef;
#pragma unroll
            for (int j = 0; j < 4; ++j) { xv[j] += gt[j] * (yv[j] * rs * po[j]); __builtin_nontemporal_store(xv[j], (f32x4*)(P.out + (size_t)m * DM + lo + 256 * j)); }
        }
        if (mode != 2) {
            float ss = 0.f;
#pragma unroll
            for (int j = 0; j < 4; ++j) ss += (xv[j][0] * xv[j][0] + xv[j][1] * xv[j][1]) + (xv[j][2] * xv[j][2] + xv[j][3] * xv[j][3]);
            const float rs = rsqrtf(wave_sum(ss) * (1.0f / DM) + EPS);
#pragma unroll
            for (int j = 0; j < 4; ++j) { const f32x4 h = (xv[j] * rs * pr[j]) * (1.0f + sc[j]) + sh[j];
                u32x2 o; o.x = pk(h[0], h[1]); o.y = pk(h[2], h[3]);
                *(u32x2*)(H + (size_t)m * DM + lo + 256 * j) = o; }
        }
    }
#undef ROW_XS
}

__device__ __forceinline__ void cache_kr_job(const Params& P, unsigned char* ws, int l, int gtid, int gthreads) {
    bf16* Klat = (bf16*)(ws + WS_K) + K_CTX_ROWS * 96;
    for (int it = gtid; it < 2048 * 8 * 4; it += gthreads) {
        const int c8 = (it & 3) * 8, h = (it >> 2) & 7, j = it >> 5, b = j >> 9, key = j & 511;
        const float* s = P.cache_kr + ((size_t)(b * 2 + l) * 512 + key) * 32;
        float v[8];
#pragma unroll
        for (int i = 0; i < 8; ++i) v[i] = s[kr_logical(c8 + i)];
        u32x4 o; o.x = pk(v[0], v[1]); o.y = pk(v[2], v[3]); o.z = pk(v[4], v[5]); o.w = pk(v[6], v[7]);
        *(u32x4*)(Klat + ((size_t)(b * 8 + h) * 4608 + 4096 + key) * 96 + 64 + c8) = o;
    }
}
__device__ __forceinline__ void ckv_out_job(const Params& P, unsigned char* ws, int l, int gtid, int gthreads) {
    const float* kvf = (const float*)(ws + WS_KVF32); const float* ssq = (const float*)(ws + WS_SSQ) + (size_t)(l * 2 + 1) * MT;
    for (int it = gtid; it < MC * 32; it += gthreads) {
        const int row = it >> 5, c4 = (it & 31) * 4;
        const float rs = rsqrtf(ssq[row] * (1.0f / 128.0f) + EPS);
        const f32x4 v = *(const f32x4*)(kvf + (size_t)row * 128 + c4), g = *(const f32x4*)(P.kv_norm + l * 128 + c4);
        *(f32x4*)(P.out + OUT_CKV + ((size_t)((row >> 8) * 2 + l) * 256 + (row & 255)) * 128 + c4) = v * rs * g;
    }
}
__device__ __forceinline__ void pool_job(const Params& P, unsigned char* ws, int gtid, int gthreads) {
    const bf16* pu = (const bf16*)(ws + WS_PU); bf16* yp = (bf16*)(ws + WS_YPOOL);
    for (int it = gtid; it < MT * 64; it += gthreads) {
        const int row = it >> 6, c8 = (it & 63) * 8, hw = 1 << (c8 >> 7);
        int t, n, r0; if (row < MC) { t = row & 255; n = 256; r0 = row - t; } else { t = (row - MC) & 4095; n = 4096; r0 = row - t; }
        const int lo = max(t - hw, 0), hi = min(t + hw, n);
        float s[8] = {0.f, 0.f, 0.f, 0.f, 0.f, 0.f, 0.f, 0.f};
        u32x4 wv[16];
#pragma unroll
        for (int k = 0; k < 16; ++k) { const int q = lo + k; wv[k] = (u32x4){0u, 0u, 0u, 0u}; if (q < hi) wv[k] = *(const u32x4*)(pu + (size_t)(r0 + q) * 512 + c8); }
#pragma unroll
        for (int k = 0; k < 16; ++k) { const u32x4 w = wv[k];
            s[0] += bflo(w.x); s[1] += bfhi(w.x); s[2] += bflo(w.y); s[3] += bfhi(w.y); s[4] += bflo(w.z); s[5] += bfhi(w.z); s[6] += bflo(w.w); s[7] += bfhi(w.w); }
        const float inv = 1.0f / (float)(hi - lo);
        const u32x4 w = *(const u32x4*)(pu + (size_t)row * 512 + c8);
        u32x4 o; o.x = pk(s[0] * inv - bflo(w.x), s[1] * inv - bfhi(w.x)); o.y = pk(s[2] * inv - bflo(w.y), s[3] * inv - bfhi(w.y));
        o.z = pk(s[4] * inv - bflo(w.z), s[5] * inv - bfhi(w.z)); o.w = pk(s[6] * inv - bflo(w.w), s[7] * inv - bfhi(w.w));
        *(u32x4*)(yp + (size_t)row * 512 + c8) = o;
    }
}

#define MFMA16(a, b, c) __builtin_amdgcn_mfma_f32_16x16x32_bf16((a), (b), (c), 0, 0, 0)
constexpr int AT_KS = 208, AT_VS = 144, AT_VOFF = 64 * 208, AT_BUF = 64 * 208 + 64 * 144;
__device__ __forceinline__ bf16x8 mk8(u32x2 lo, u32x2 hi) { u32x4 w = {lo.x, lo.y, hi.x, hi.y}; return __builtin_bit_cast(bf16x8, w); }

__device__ __forceinline__ void attn_phase(const Params& P, unsigned char* ws, LAS unsigned char* lds, int tid, int wave, int lane) {
    const bf16* Q = (const bf16*)(ws + WS_Q); const bf16* Kctx = (const bf16*)(ws + WS_K); const bf16* Klat = Kctx + K_CTX_ROWS * 96;
    const bf16* Vctx = (const bf16*)(ws + WS_VT); const bf16* Vlat = Vctx + V_CTX_ROWS * 256; bf16* oa = (bf16*)(ws + WS_QKC);
    const int fr = lane & 15, fq = lane >> 4;
    const int q1 = tid + 512, k0r = tid / 12, k0c = tid - k0r * 12, k1r = q1 / 12, k1c = q1 - k1r * 12, ve = tid >> 3, vc = tid & 7;
    for (int ui0 = blockIdx.x; ui0 < 640; ui0 += gridDim.x) {
        int ui = ui0;
        if (ui0 < 512 && gridDim.x == 256) { const int k = ui0 >> 8, c = ui0 & 255, x = c & 7, j = c >> 3; ui = ((k * 16 + x * 2 + (j >> 4)) << 4) + (j & 15); }
        int h, nk, qrow0; const bf16 *Kb, *Vb;
        if (ui < 512) { const int b = ui >> 7, qb = ui & 15; h = (ui >> 4) & 7; nk = 4608; qrow0 = MC + b * 4096 + qb * 256; Kb = Klat + (size_t)(b * 8 + h) * 4608 * 96; Vb = Vlat + (size_t)(b * 8 + h) * 64 * 4608; }
        else { const int v = ui - 512, b = v >> 3; h = v & 7; nk = 256; qrow0 = b * 256; Kb = Kctx + (size_t)(b * 8 + h) * 256 * 96; Vb = Vctx + (size_t)(b * 8 + h) * 64 * 256; }
        const int nt = nk >> 6;
        bf16x8 qf[2][3];
#pragma unroll
        for (int ib = 0; ib < 2; ++ib)
#pragma unroll
            for (int ks = 0; ks < 3; ++ks) qf[ib][ks] = *(const bf16x8*)(Q + (size_t)(qrow0 + wave * 32 + ib * 16 + fr) * 768 + h * 96 + ks * 32 + fq * 8);
        f32x4 o[4][2];
#pragma unroll
        for (int eb = 0; eb < 4; ++eb) { o[eb][0] = (f32x4){0.f, 0.f, 0.f, 0.f}; o[eb][1] = (f32x4){0.f, 0.f, 0.f, 0.f}; }
        float mrun[2] = {-1e30f, -1e30f}, lrun[2] = {0.f, 0.f};
        u32x4 kr0, kr1 = {0u, 0u, 0u, 0u}, vr;
#define AT_LOAD(t) do { const bf16* kt_ = Kb + (size_t)(t) * 64 * 96; kr0 = *(const u32x4*)(kt_ + tid * 8); if (tid < 256) kr1 = *(const u32x4*)(kt_ + q1 * 8); \
        vr = *(const u32x4*)(Vb + (size_t)ve * nk + (t) * 64 + vc * 8); } while (0)
#define AT_STORE(buf) do { LAS unsigned char* B_ = lds + (buf) * AT_BUF; *(LAS u32x4*)(B_ + k0r * AT_KS + k0c * 16) = kr0; if (tid < 256) *(LAS u32x4*)(B_ + k1r * AT_KS + k1c * 16) = kr1; \
        *(LAS u32x4*)(B_ + AT_VOFF + ve * AT_VS + vc * 16) = vr; } while (0)
        AT_LOAD(0); AT_STORE(0); __syncthreads();
        for (int t = 0; t < nt; ++t) {
            if (t + 1 < nt) AT_LOAD(t + 1);
            const LAS unsigned char* B = lds + (t & 1) * AT_BUF;
            f32x4 s[4][2];
            __builtin_amdgcn_s_setprio(1);
#pragma unroll
            for (int jb = 0; jb < 4; ++jb) {
                bf16x8 kf[3];
#pragma unroll
                for (int ks = 0; ks < 3; ++ks) kf[ks] = *(const LAS bf16x8*)(B + (jb * 16 + fr) * AT_KS + ks * 64 + fq * 16);
#pragma unroll
                for (int ib = 0; ib < 2; ++ib) { f32x4 a = {0.f, 0.f, 0.f, 0.f};
#pragma unroll
                    for (int ks = 0; ks < 3; ++ks) a = MFMA16(kf[ks], qf[ib][ks], a);
                    s[jb][ib] = a; }
            }
            __builtin_amdgcn_s_setprio(0);
            bf16x8 pb[2][2];
#pragma unroll
            for (int ib = 0; ib < 2; ++ib) {
                float mx = -1e30f;
#pragma unroll
                for (int jb = 0; jb < 4; ++jb) mx = fmaxf(mx, fmaxf(fmaxf(s[jb][ib][0], s[jb][ib][1]), fmaxf(s[jb][ib][2], s[jb][ib][3])));
                mx = fmaxf(mx, __shfl_xor(mx, 16)); mx = fmaxf(mx, __shfl_xor(mx, 32));
                const float mnew = fmaxf(mrun[ib], mx), alpha = fast_exp2(mrun[ib] - mnew); mrun[ib] = mnew;
                float ls = 0.f;
#pragma unroll
                for (int jb = 0; jb < 4; ++jb)
#pragma unroll
                    for (int r = 0; r < 4; ++r) { const float p = fast_exp2(s[jb][ib][r] - mnew); s[jb][ib][r] = p; ls += p; }
                lrun[ib] = lrun[ib] * alpha + ls;
#pragma unroll
                for (int eb = 0; eb < 4; ++eb) o[eb][ib] *= alpha;
                pb[0][ib] = __builtin_bit_cast(bf16x8, pack8(s[0][ib], s[1][ib])); pb[1][ib] = __builtin_bit_cast(bf16x8, pack8(s[2][ib], s[3][ib]));
            }
            __builtin_amdgcn_s_setprio(1);
#pragma unroll
            for (int eb = 0; eb < 4; ++eb)
#pragma unroll
                for (int kk = 0; kk < 2; ++kk) {
                    const LAS unsigned char* vp = B + AT_VOFF + (eb * 16 + fr) * AT_VS + fq * 8;
                    const bf16x8 vf = mk8(*(const LAS u32x2*)(vp + (2 * kk) * 32), *(const LAS u32x2*)(vp + (2 * kk + 1) * 32));
                    o[eb][0] = MFMA16(vf, pb[kk][0], o[eb][0]); o[eb][1] = MFMA16(vf, pb[kk][1], o[eb][1]);
                }
            __builtin_amdgcn_s_setprio(0);
            if (t + 1 < nt) AT_STORE((t + 1) & 1);
            __syncthreads();
        }
#pragma unroll
        for (int ib = 0; ib < 2; ++ib) {
            float l = lrun[ib]; l += __shfl_xor(l, 16); l += __shfl_xor(l, 32);
            const float inv = 1.0f / l;
            bf16* op = oa + (size_t)(qrow0 + wave * 32 + ib * 16 + fr) * 512 + h * 64 + fq * 4;
#pragma unroll
            for (int eb = 0; eb < 4; ++eb) { const f32x4 v = o[eb][ib] * inv; u32x2 w; w.x = pk(v[0], v[1]); w.y = pk(v[2], v[3]); *(u32x2*)(op + eb * 16) = w; }
        }
    }
#undef AT_LOAD
#undef AT_STORE
}

constexpr int RT_S = 272, RT_TILE = 128 * 272;
#define TSW_WBASE(cc, j) ((cc) * 8 * RT_S + (((((j) >> 3) ^ (cc)) & 15) << 4) + ((j) & 7) * 2)
#define TSW_RIMM(X, ks) ((X) * 16 * RT_S + ((((ks) << 2) ^ ((X) << 1)) & ~3) * 16)
__device__ __forceinline__ unsigned short f2bf1(float v) { return (unsigned short)(pk(v, 0.f) & 0xffffu); }
__device__ __forceinline__ void ret_decode(int ui, int& b, int& h, int& c, int& row0, bool& lat) {
    if (ui < 512) { lat = true; b = ui >> 7; h = (ui >> 5) & 3; c = ui & 31; row0 = MC + b * 4096 + c * 128; }
    else { const int v = ui - 512; lat = false; b = v >> 3; h = (v >> 1) & 3; c = v & 1; row0 = b * 256 + c * 128; }
}
__device__ __forceinline__ void ret_u_phase(const Params& P, unsigned char* ws, int l, LAS unsigned char* lds, int tid, int wave, int lane) {
    const bf16* rk = (const bf16*)(ws + WS_RK); const bf16* rv = (const bf16*)(ws + WS_RV);
    LAS unsigned char* Kt = lds; LAS unsigned char* Vf = lds + RT_TILE; LAS unsigned char* Vb = lds + 2 * RT_TILE;
    const int fr = lane & 15, fq = lane >> 4;
    for (int ui = blockIdx.x; ui < 640; ui += gridDim.x) {
        int b, h, c, row0; bool lat; ret_decode(ui, b, h, c, row0, lat);
        const float lgf2 = -expf(P.ret_decay[(l * 2 + 0) * 4 + h]) * LOG2E, lgb2 = -expf(P.ret_decay[(l * 2 + 1) * 4 + h]) * LOG2E;
#pragma unroll
        for (int i = 0; i < 4; ++i) {
            const int q = tid + 512 * i, j = q >> 4, cc = q & 15;
            const u32x4 kw = *(const u32x4*)(rk + (size_t)(row0 + j) * 512 + h * 128 + cc * 8), vw = *(const u32x4*)(rv + (size_t)(row0 + j) * 512 + h * 128 + cc * 8);
            const float sf = fast_exp2(lgf2 * (float)(127 - j)), sb = fast_exp2(lgb2 * (float)j);
            const unsigned kwa[4] = {kw.x, kw.y, kw.z, kw.w}, vwa[4] = {vw.x, vw.y, vw.z, vw.w};
            const int wb = TSW_WBASE(cc, j);
#pragma unroll
            for (int e2 = 0; e2 < 4; ++e2) {
                const int wo = wb + e2 * 2 * RT_S;
                *(LAS unsigned short*)(Kt + wo) = (unsigned short)(kwa[e2] & 0xffffu); *(LAS unsigned short*)(Kt + wo + RT_S) = (unsigned short)(kwa[e2] >> 16);
                const float v0 = bflo(vwa[e2]), v1 = bfhi(vwa[e2]);
                *(LAS unsigned short*)(Vf + wo) = f2bf1(v0 * sf); *(LAS unsigned short*)(Vf + wo + RT_S) = f2bf1(v1 * sf);
                *(LAS unsigned short*)(Vb + wo) = f2bf1(v0 * sb); *(LAS unsigned short*)(Vb + wo + RT_S) = f2bf1(v1 * sb);
            }
        }
        __syncthreads();
        const int rb[2] = {fr * RT_S + ((fq ^ (fr >> 3)) << 4), fr * RT_S + (((fq ^ (fr >> 3)) ^ 2) << 4)};
        f32x4 af[8], ab[8];
#pragma unroll
        for (int db = 0; db < 8; ++db) { af[db] = (f32x4){0.f, 0.f, 0.f, 0.f}; ab[db] = (f32x4){0.f, 0.f, 0.f, 0.f}; }
#pragma unroll
        for (int ks = 0; ks < 4; ++ks) {
            const int vo = (wave * 16 + fr) * RT_S + (((((ks << 2) | fq) ^ ((wave << 1) | (fr >> 3))) & 15) << 4);
            const bf16x8 vf = *(const LAS bf16x8*)(Vf + vo), vb = *(const LAS bf16x8*)(Vb + vo);
#pragma unroll
            for (int db = 0; db < 8; ++db) { const bf16x8 kf = *(const LAS bf16x8*)(Kt + rb[db & 1] + TSW_RIMM(db, ks));
                af[db] = MFMA16(vf, kf, af[db]); ab[db] = MFMA16(vb, kf, ab[db]); }
        }
        const int bh = b * 4 + h;
        __syncthreads();
        if (lat) {
            LAS unsigned char* Tf = lds; LAS unsigned char* Tb = lds + RT_TILE;
#pragma unroll
            for (int db = 0; db < 8; ++db)
#pragma unroll
                for (int r = 0; r < 4; ++r) { const int off = (wave * 16 + fq * 4 + r) * RT_S + (db * 16 + fr) * 2;
                    *(LAS unsigned short*)(Tf + off) = f2bf1(af[db][r]); *(LAS unsigned short*)(Tb + off) = f2bf1(ab[db][r]); }
            __syncthreads();
            bf16* Uf = (bf16*)(ws + WS_ULAT) + ((size_t)((bh * 2 + 0) * 32 + c)) * 16384; bf16* Ub = (bf16*)(ws + WS_ULAT) + ((size_t)((bh * 2 + 1) * 32 + c)) * 16384;
#pragma unroll
            for (int i = 0; i < 4; ++i) { const int q = tid + 512 * i, row = q >> 4, cc = q & 15;
                *(u32x4*)(Uf + row * 128 + cc * 8) = *(const LAS u32x4*)(Tf + row * RT_S + cc * 16); *(u32x4*)(Ub + row * 128 + cc * 8) = *(const LAS u32x4*)(Tb + row * RT_S + cc * 16); }
        } else {
            LAS unsigned char* Tf = lds; LAS unsigned char* Tb = lds + 128 * 528;
#pragma unroll
            for (int db = 0; db < 8; ++db)
#pragma unroll
                for (int r = 0; r < 4; ++r) { const int off = (wave * 16 + fq * 4 + r) * 528 + (db * 16 + fr) * 4;
                    *(LAS float*)(Tf + off) = af[db][r]; *(LAS float*)(Tb + off) = ab[db][r]; }
            __syncthreads();
            float* Uf = (float*)(ws + WS_UCTX) + ((size_t)((bh * 2 + 0) * 2 + c)) * 16384; float* Ub = (float*)(ws + WS_UCTX) + ((size_t)((bh * 2 + 1) * 2 + c)) * 16384;
#pragma unroll
            for (int i = 0; i < 8; ++i) { const int q = tid + 512 * i, row = q >> 5, cc = q & 31;
                *(f32x4*)(Uf + row * 128 + cc * 4) = *(const LAS f32x4*)(Tf + row * 528 + cc * 16); *(f32x4*)(Ub + row * 128 + cc * 4) = *(const LAS f32x4*)(Tb + row * 528 + cc * 16); }
        }
        __syncthreads();
    }
}
__device__ __forceinline__ void ret_scan_phase(const Params& P, unsigned char* ws, int l, int gtid, int gthreads) {
    for (int it = gtid; it < 32 * 16384; it += gthreads) {
        const int off = it & 16383, bhd = it >> 14, dir = bhd & 1, bh = bhd >> 1, b = bh >> 2, h = bh & 3, e = off >> 7, dp = off & 127, dl = (dp >> 1) + ((dp & 1) << 6);
        float s = P.state_ret[((((size_t)(b * 2 + l) * 2 + dir) * 4 + h) * 128 + dl) * 128 + e];
        const float dec = fast_exp2(-expf(P.ret_decay[(l * 2 + dir) * 4 + h]) * LOG2E * 128.0f);
        bf16* U = (bf16*)(ws + WS_ULAT) + (size_t)bhd * 32 * 16384 + off;
        const int c0 = dir ? 31 : 0, cs = dir ? -1 : 1;
        float u[32];
#pragma unroll
        for (int c = 0; c < 32; ++c) u[c] = bf2f(U[(size_t)(c0 + cs * c) * 16384]);
#pragma unroll
        for (int c = 0; c < 32; ++c) { U[(size_t)(c0 + cs * c) * 16384] = f2bf1(s); s = dec * s + u[c]; }
    }
#pragma unroll 4
    for (int it = gtid; it < 128 * 16384; it += gthreads) {
        const int off = it & 16383, bhd = it >> 14, dir = bhd & 1, bh = bhd >> 1, b = bh >> 2, h = bh & 3, e = off >> 7, dp = off & 127, dl = (dp >> 1) + ((dp & 1) << 6);
        const float dec = fast_exp2(-expf(P.ret_decay[(l * 2 + dir) * 4 + h]) * LOG2E * 128.0f);
        const float* U = (const float*)(ws + WS_UCTX) + (size_t)bhd * 2 * 16384 + off; bf16* S = (bf16*)(ws + WS_SCTX) + (size_t)bhd * 2 * 16384 + off;
        const float u0 = U[0], u1 = U[16384]; float s;
        if (dir == 0) { S[0] = 0; S[16384] = f2bf1(u0); s = dec * u0 + u1; }
        else { S[16384] = 0; S[0] = f2bf1(u1); s = dec * u1 + u0; }
        P.out[OUT_ST + ((((size_t)(b * 2 + l) * 2 + dir) * 4 + h) * 128 + dl) * 128 + e] = s;
    }
}
__device__ __forceinline__ bf16x8 scale8(bf16x8 q, float s) {
    const u32x4 w = __builtin_bit_cast(u32x4, q); u32x4 o;
    o.x = pk(bflo(w.x) * s, bfhi(w.x) * s); o.y = pk(bflo(w.y) * s, bfhi(w.y) * s); o.z = pk(bflo(w.z) * s, bfhi(w.z) * s); o.w = pk(bflo(w.w) * s, bfhi(w.w) * s);
    return __builtin_bit_cast(bf16x8, o);
}
__device__ __forceinline__ void ret_out_phase(const Params& P, unsigned char* ws, int l, LAS unsigned char* lds, int tid, int wave, int lane, bf16* dst) {
    const bf16* rq = (const bf16*)(ws + WS_RQ); const bf16* rk = (const bf16*)(ws + WS_RK); const bf16* rv = (const bf16*)(ws + WS_RV); bf16* rgs = (bf16*)(ws + WS_RGS);
    LAS unsigned char* Ks = lds; LAS unsigned char* Vt = lds + RT_TILE;
    const int fr = lane & 15, fq = lane >> 4, iloc = wave * 16 + fr;
    for (int ui = blockIdx.x; ui < 640; ui += gridDim.x) {
        int b, h, c, row0; bool lat; ret_decode(ui, b, h, c, row0, lat);
        const float lgf2 = -expf(P.ret_decay[(l * 2 + 0) * 4 + h]) * LOG2E, lgb2 = -expf(P.ret_decay[(l * 2 + 1) * 4 + h]) * LOG2E;
        const int bh = b * 4 + h;
        const bf16* Sf = lat ? (const bf16*)(ws + WS_ULAT) + ((size_t)((bh * 2 + 0) * 32 + c)) * 16384 : (const bf16*)(ws + WS_SCTX) + ((size_t)((bh * 2 + 0) * 2 + c)) * 16384;
        const bf16* Sb = lat ? (const bf16*)(ws + WS_ULAT) + ((size_t)((bh * 2 + 1) * 32 + c)) * 16384 : (const bf16*)(ws + WS_SCTX) + ((size_t)((bh * 2 + 1) * 2 + c)) * 16384;
#pragma unroll
        for (int i = 0; i < 4; ++i) {
            const int q = tid + 512 * i, j = q >> 4, cc = q & 15;
            const u32x4 kw = *(const u32x4*)(rk + (size_t)(row0 + j) * 512 + h * 128 + cc * 8), vw = *(const u32x4*)(rv + (size_t)(row0 + j) * 512 + h * 128 + cc * 8);
            *(LAS u32x4*)(Ks + j * RT_S + cc * 16) = kw;
            *(LAS u32x4*)(lds + 2 * RT_TILE + j * RT_S + cc * 16) = *(const u32x4*)(Sf + (size_t)j * 128 + cc * 8);
            *(LAS u32x4*)(lds + 3 * RT_TILE + j * RT_S + cc * 16) = *(const u32x4*)(Sb + (size_t)j * 128 + cc * 8);
            const unsigned vwa[4] = {vw.x, vw.y, vw.z, vw.w};
#pragma unroll
            for (int e2 = 0; e2 < 4; ++e2) { const int wo = TSW_WBASE(cc, j) + e2 * 2 * RT_S;
                *(LAS unsigned short*)(Vt + wo) = (unsigned short)(vwa[e2] & 0xffffu); *(LAS unsigned short*)(Vt + wo + RT_S) = (unsigned short)(vwa[e2] >> 16); }
        }
        bf16x8 qf[4];
#pragma unroll
        for (int ks = 0; ks < 4; ++ks) qf[ks] = *(const bf16x8*)(rq + (size_t)(row0 + iloc) * 512 + h * 128 + ks * 32 + fq * 8);
        __syncthreads();
        f32x4 s[8];
#pragma unroll
        for (int jb = 0; jb < 8; ++jb) { f32x4 a = {0.f, 0.f, 0.f, 0.f};
#pragma unroll
            for (int ks = 0; ks < 4; ++ks) { const bf16x8 kf = *(const LAS bf16x8*)(Ks + (jb * 16 + fr) * RT_S + (ks * 32 + fq * 8) * 2); a = MFMA16(kf, qf[ks], a); }
#pragma unroll
            for (int r = 0; r < 4; ++r) { const int diff = iloc - (jb * 16 + fq * 4 + r);
                const float w = (diff >= 0 ? fast_exp2(lgf2 * (float)diff) : 0.f) + (diff <= 0 ? fast_exp2(-lgb2 * (float)diff) : 0.f); a[r] *= w; }
            s[jb] = a; }
        const int vrb = fr * RT_S + (((fq >> 1) ^ (fr >> 3)) << 4) + (fq & 1) * 8;
        f32x4 o[8];
#pragma unroll
        for (int eb = 0; eb < 8; ++eb) o[eb] = (f32x4){0.f, 0.f, 0.f, 0.f};
#pragma unroll
        for (int kk = 0; kk < 4; ++kk) {
            const bf16x8 pb = __builtin_bit_cast(bf16x8, pack8(s[2 * kk], s[2 * kk + 1]));
#pragma unroll
            for (int eb = 0; eb < 8; ++eb) { const LAS unsigned char* vp = Vt + vrb + eb * 16 * RT_S;
                const bf16x8 vf = mk8(*(const LAS u32x2*)(vp + (((4 * kk) ^ (eb << 1)) & 15) * 16), *(const LAS u32x2*)(vp + (((4 * kk + 2) ^ (eb << 1)) & 15) * 16));
                o[eb] = MFMA16(vf, pb, o[eb]); }
        }
        const float qdf = fast_exp2(lgf2 * (float)(iloc + 1)), qdb = fast_exp2(lgb2 * (float)(128 - iloc));
#pragma unroll
        for (int ks = 0; ks < 4; ++ks) {
            const bf16x8 qsf = scale8(qf[ks], qdf), qsb = scale8(qf[ks], qdb);
#pragma unroll
            for (int eb = 0; eb < 8; ++eb) {
                const bf16x8 a_f = *(const LAS bf16x8*)(lds + 2 * RT_TILE + (eb * 16 + fr) * RT_S + (ks * 32 + fq * 8) * 2), a_b = *(const LAS bf16x8*)(lds + 3 * RT_TILE + (eb * 16 + fr) * RT_S + (ks * 32 + fq * 8) * 2);
                o[eb] = MFMA16(a_f, qsf, o[eb]); o[eb] = MFMA16(a_b, qsb, o[eb]); }
        }
        float ss = 0.f;
#pragma unroll
        for (int eb = 0; eb < 8; ++eb) ss += (o[eb][0] * o[eb][0] + o[eb][1] * o[eb][1]) + (o[eb][2] * o[eb][2] + o[eb][3] * o[eb][3]);
        ss += __shfl_xor(ss, 16); ss += __shfl_xor(ss, 32);
        const float rs = rsqrtf(ss * (1.0f / 128.0f) + EPS);
        bf16* gp = rgs + (size_t)(row0 + iloc) * 512 + h * 128 + fq * 4;
#pragma unroll
        for (int eb = 0; eb < 8; ++eb) { const u32x2 g = *(const u32x2*)(gp + eb * 16);
            u32x2 w; w.x = pk(o[eb][0] * rs * bflo(g.x), o[eb][1] * rs * bfhi(g.x)); w.y = pk(o[eb][2] * rs * bflo(g.y), o[eb][3] * rs * bfhi(g.y));
            *(u32x2*)(dst + (gp - rgs) + eb * 16) = w; }
        __syncthreads();
    }
}

constexpr size_t WS_BAR = 896 * 1024;
#define XB_TMO      128
#define XB_XCNT(j)  (256  + 64 * (j))
#define XB_XSUB(j)  (1280 + 64 * (j))
#define XB_XGEN(j)  (2304 + 64 * (j))
#define XB_TOP      3328
#define XB_TOPGEN   3392
#define XCD_BAR_WORDS 3456
#define XB_SPIN_CAP (1u << 18)

__device__ __forceinline__ unsigned xb_ld(unsigned* p)              { return __hip_atomic_load(p, __ATOMIC_RELAXED, __HIP_MEMORY_SCOPE_AGENT); }
__device__ __forceinline__ unsigned xb_add(unsigned* p, unsigned v) { return __hip_atomic_fetch_add(p, v, __ATOMIC_RELAXED, __HIP_MEMORY_SCOPE_AGENT); }
__device__ __forceinline__ unsigned xb_xcc_id() { return (unsigned)__builtin_amdgcn_s_getreg((3 << 11) | 20) & 0xFu; }
#define XB_SPIN(cond, bar) do { unsigned _sp = 0; while (cond) { __builtin_amdgcn_s_sleep(1); \
    if ((++_sp & 255u) == 0u) { if (xb_ld(&(bar)[XB_TMO])) break; if (_sp > XB_SPIN_CAP) { atomicAdd(&(bar)[XB_TMO], 1u); break; } } } } while (0)

struct XcdBarrier {
    unsigned* bar; unsigned x;
    volatile LAS unsigned* st;
};

__device__ __forceinline__ XcdBarrier xcd_barrier_post(unsigned* bar, volatile LAS unsigned* st) {
    XcdBarrier b; b.bar = bar; b.x = xb_xcc_id(); b.st = st;
    if (threadIdx.x == 0) (void)xb_add(&bar[XB_XCNT(b.x)], 1u);
    return b;
}
__device__ __forceinline__ void xcd_barrier_complete(unsigned* bar, unsigned x, unsigned& nloc, unsigned& nx) {
    const unsigned G = gridDim.x * gridDim.y * gridDim.z;
    unsigned sum, cnt, mine, sp = 0u;
    for (;;) {
        sum = 0u; cnt = 0u; mine = 0u;
#pragma unroll
        for (unsigned j = 0; j < 16; ++j) { const unsigned c = xb_ld(&bar[XB_XCNT(j)]); sum += c; cnt += (c > 0u) ? 1u : 0u; mine = (j == x) ? c : mine; }
        if (sum == G) break;
        __builtin_amdgcn_s_sleep(1);
        if ((++sp & 255u) == 0u) { if (xb_ld(&bar[XB_TMO])) break; if (sp > XB_SPIN_CAP) { atomicAdd(&bar[XB_TMO], 1u); break; } }
    }
    nloc = mine > 0u ? mine : 1u; nx = cnt > 0u ? cnt : 1u;
}

__device__ __forceinline__ void xcd_barrier(const XcdBarrier& b) {
    asm volatile("s_waitcnt vmcnt(0)" ::: "memory");
    __syncthreads();
    if (threadIdx.x == 0) {
        unsigned* bar = b.bar;
        __builtin_amdgcn_s_waitcnt(0);
        unsigned nloc = b.st[0], nx = b.st[1];
        if (nloc == 0u) { xcd_barrier_complete(bar, b.x, nloc, nx); b.st[0] = nloc; b.st[1] = nx; }
        const unsigned old = xb_add(&bar[XB_XSUB(b.x)], 1u);
        const unsigned gen = old / nloc;
        if (old + 1u == (gen + 1u) * nloc) {
            __builtin_amdgcn_fence(__ATOMIC_RELEASE, "agent");
            asm volatile("s_waitcnt vmcnt(0)" ::: "memory");
            const unsigned og = xb_add(&bar[XB_TOP], 1u);
            const unsigned tg = og / nx;
            if (og + 1u == (tg + 1u) * nx) xb_add(&bar[XB_TOPGEN], 1u);
            else XB_SPIN(xb_ld(&bar[XB_TOPGEN]) == tg, bar);
            __builtin_amdgcn_fence(__ATOMIC_ACQUIRE, "agent");
            xb_add(&bar[XB_XGEN(b.x)], 1u);
            asm volatile("s_waitcnt vmcnt(0)" ::: "memory");
        } else {
            XB_SPIN(xb_ld(&bar[XB_XGEN(b.x)]) == gen, bar);
            __builtin_amdgcn_fence(__ATOMIC_ACQUIRE, "agent");
            asm volatile("s_waitcnt vmcnt(0)" ::: "memory");
        }
    }
    __syncthreads();
}

constexpr int LDS_BYTES = 147456;
#ifndef REP_ATTN
#define REP_ATTN 1
#endif
#ifndef REP_FFN
#define REP_FFN 1
#endif
#ifndef REP_CONV
#define REP_CONV 1
#endif
#ifndef REP_MERGE
#define REP_MERGE 1
#endif
#ifndef REP_M2
#define REP_M2 1
#endif
#ifndef REP_WOUT
#define REP_WOUT 1
#endif
#ifndef REP_PRO
#define REP_PRO 1
#endif
#ifndef REP_POOL
#define REP_POOL 1
#endif
#ifndef REP_RETU
#define REP_RETU 1
#endif
#ifndef REP_QKV
#define REP_QKV 1
#endif
#ifndef REP_RETO
#define REP_RETO 1
#endif
#ifndef REP_WINB
#define REP_WINB 1
#endif
#ifndef REP_SYNC
#define REP_SYNC 0
#endif
template <class Epi> __device__ __forceinline__ void run_gemm(LAS unsigned char* lds, const bf16* A, const bf16* Bt, int M, int N, int K, int rot, const Epi& E) {
    pg8::Gemm g{A, Bt, M, N, K}; pg8::StaticOrder S; const int G = (int)gridDim.x; S.init(M, N, G, (int)((blockIdx.x + G - rot) % G));
    pg8::gemm_phase<Epi, pg8::StaticOrder, true, true>(lds, g, S, E);
}
#define PHASE_VIEW() \
    int tid = threadIdx.x; asm volatile("" : "+v"(tid)); unsigned char* ws = P.ws; asm volatile("" : "+s"(ws)); \
    const int lane = tid & 63, wave = __builtin_amdgcn_readfirstlane(tid >> 6); \
    const int G = gridDim.x, gw = blockIdx.x * 8 + wave, ngw = G * 8, gtid = blockIdx.x * 512 + tid, gthreads = G * 512; \
    LAS float* scr = (LAS float*)(lds + wave * 8448); unsigned char* wa = ws + WS_W; \
    (void)lane; (void)G; (void)gw; (void)ngw; (void)gtid; (void)gthreads; (void)scr; (void)wa;
#define GSYNC() do { XcdBarrier xb_; xb_.bar = (unsigned*)(P.ws + WS_BAR); xb_.x = (unsigned)__builtin_amdgcn_readfirstlane((int)xbar.x); xb_.st = (volatile LAS unsigned*)((LAS unsigned char*)lds + LDS_BYTES - 64); xcd_barrier(xb_); } while (0)

#define CONV_VIEW() const bool csk = (int)gridDim.x > 128; const int cgw = csk ? ((int)blockIdx.x - 64) * 8 + wave : gw, cngw = csk ? ((int)gridDim.x - 64) * 8 : ngw; const bool cdo = !csk || (int)blockIdx.x >= 64
__device__ __forceinline__ void ffn_phases(const Params& P, const XcdBarrier& xbar, LAS unsigned char* lds, int job, int l) {
    for (int rep = 0; rep < REP_FFN; ++rep) { PHASE_VIEW(); run_gemm(lds, (const bf16*)(ws + WS_H), (const bf16*)(wa + WA_GU), MT, 2 * DFF, DM, 0, EpiGU{(bf16*)(ws + WS_ACT)}); }
    GSYNC();
    for (int rep = 0; rep < REP_FFN; ++rep) { PHASE_VIEW(); run_gemm(lds, (const bf16*)(ws + WS_ACT), (const bf16*)(wa + WA_D), MT, DM, DFF, 0, EpiBf16{(bf16*)(ws + WS_YF), DM}); }
    { PHASE_VIEW(); CONV_VIEW();
      if (cdo) { if (job == 1) conv_win(P, ws, l, scr, cgw, cngw, lane);
                 else if (job == 2) conv_job(P.ffn1_gu + (size_t)DM * 2 * DFF, DM, 2 * DFF, (bf16*)(ws + WS_W + WA_GU), DM, 2 * DFF, 1, nullptr, scr, cgw, cngw, lane); } }
    GSYNC();
    for (int rep = 0; rep < REP_SYNC; ++rep) GSYNC();
}

__global__ void __launch_bounds__(512, 2) fwd_kernel(Params P) {
    extern __shared__ __attribute__((aligned(16))) unsigned char lds_raw[];
    cg::grid_group grid = cg::this_grid();
    LAS unsigned char* lds = (LAS unsigned char*)lds_raw;
    volatile LAS unsigned* xst = (volatile LAS unsigned*)(lds + LDS_BYTES - 64);
    if (threadIdx.x < 2) xst[threadIdx.x] = 0u;
    __syncthreads();
    const XcdBarrier xbar = xcd_barrier_post((unsigned*)(P.ws + WS_BAR), xst);

    { PHASE_VIEW();
      for (int rep = 0; rep < REP_PRO; ++rep) { conv_ffn(P.ffn1_gu, P.ffn1_d, ws, scr, gw, ngw, lane);
      mod_phase(P, ws, (LAS float*)(lds + 8 * 8448), tid, wave, lane); }
      tables_phase(P, ws, gtid, gthreads); }
    if (P.ws == nullptr) grid.sync();
    GSYNC();
    { PHASE_VIEW(); row_phase(P, ws, 0, nullptr, 0, 0, 0.f, 0, 0, true, gw, ngw, lane); }
    GSYNC();
#pragma unroll 1
    for (int l = 0; l < 2; ++l) {
        ffn_phases(P, xbar, lds, 1, l);
        { PHASE_VIEW();
          row_phase(P, ws, 1, (const bf16*)(ws + WS_YF), l, 0, 0.5f, l, 1, l == 0, gw, ngw, lane);
          for (int rep = 0; rep < REP_CONV; ++rep) conv_mixer(P, ws, l, scr, gw, ngw, lane, gtid, gthreads); }
        GSYNC();
        { PHASE_VIEW();
          run_gemm(lds, (const bf16*)(ws + WS_H), (const bf16*)(wa + WA_INB), MT, 3072, DM, 0, EpiWinB{ws, P.out, l});
          cache_kr_job(P, ws, l, gtid, gthreads); }
        GSYNC();
        { PHASE_VIEW();
          const float* ssq = (const float*)(ws + WS_SSQ) + (size_t)l * 2 * MT;
          bf16* QKC = (bf16*)(ws + WS_QKC); bf16* Kctx = (bf16*)(ws + WS_K); bf16* Klat = Kctx + K_CTX_ROWS * 96; bf16* Vctx = (bf16*)(ws + WS_VT); bf16* Vlat = Vctx + V_CTX_ROWS * 256;
          const bf16* kvc = QKC + (size_t)MT * 256; const bf16* ca = (const bf16*)(ws + WS_CACHEA);
          for (int rep = 0; rep < REP_QKV; ++rep) {
          run_gemm(lds, QKC, (const bf16*)(wa + WA_UQ), MT, 768, 256, 0, EpiQ{(bf16*)(ws + WS_Q), ssq, (const float2*)(ws + WS_ROPE8)});
          run_gemm(lds, kvc, (const bf16*)(wa + WA_KF), MT, 512, 256, 240 % G, EpiK{Kctx, Klat, ssq + MT, 0});
          run_gemm(lds, ca, (const bf16*)(wa + WA_KP), 2048, 512, 256, 144 % G, EpiK{Kctx, Klat, ssq + MT, 1});
          run_gemm(lds, (const bf16*)(wa + WA_VF), kvc, 512, MT, 256, 160 % G, EpiVt{Vctx, Vlat, ssq + MT, 0});
          run_gemm(lds, (const bf16*)(wa + WA_VP), ca, 512, 2048, 256, 64 % G, EpiVt{Vctx, Vlat, ssq + MT, 1}); } }
        { PHASE_VIEW();
          for (int rep = 0; rep < REP_POOL; ++rep) pool_job(P, ws, gtid, gthreads);
          for (int rep = 0; rep < REP_RETU; ++rep) ret_u_phase(P, ws, l, lds, tid, wave, lane);
          ckv_out_job(P, ws, l, gtid, gthreads); }
        GSYNC();
        { PHASE_VIEW(); ret_scan_phase(P, ws, l, gtid, gthreads); }
        for (int rep = 0; rep < REP_ATTN; ++rep) { PHASE_VIEW(); attn_phase(P, ws, lds, tid, wave, lane); }
        GSYNC();
        for (int rep = 1; rep < REP_RETO; ++rep) { PHASE_VIEW(); ret_out_phase(P, ws, l, lds, tid, wave, lane, (bf16*)(ws + WS_VT)); }
        { PHASE_VIEW(); ret_out_phase(P, ws, l, lds, tid, wave, lane, (bf16*)(ws + WS_RGS)); }
        GSYNC();
        { PHASE_VIEW(); run_gemm(lds, (const bf16*)(ws + WS_H), (const bf16*)(wa + WA_ING), MT, 3072, DM, 0, EpiBf16{(bf16*)(ws + WS_GF), 3072}); }
        GSYNC();
        { PHASE_VIEW(); run_gemm(lds, (const bf16*)(ws + WS_QKC), (const bf16*)(wa + WA_BA), MT, DM, 512, 0, EpiBf16{(bf16*)(ws + WS_H), DM}); }
        { PHASE_VIEW(); run_gemm(lds, (const bf16*)(ws + WS_RGS), (const bf16*)(wa + WA_BR), MT, DM, 512, 64 % G, EpiBf16{(bf16*)(ws + WS_BF2), DM}); }
        { PHASE_VIEW(); run_gemm(lds, (const bf16*)(ws + WS_YPOOL), (const bf16*)(wa + WA_EFF), MT, DM, 512, 128 % G, EpiBf16{(bf16*)(ws + WS_SG), DM}); }
        GSYNC();
        { PHASE_VIEW(); const u32x2* G3 = (const u32x2*)(ws + WS_GF); const u32x2* B0 = (const u32x2*)(ws + WS_H); const u32x2* B1 = (const u32x2*)(ws + WS_BF2); u32x2* S = (u32x2*)(ws + WS_SG);
#pragma unroll 4
          for (int i = gtid; i < MT * DM / 4; i += gthreads) { const int row = i >> 8, c4 = i & 255; const u32x2* gp = G3 + (size_t)row * 768 + c4;
              const u32x2 ga = __builtin_nontemporal_load(gp), gb = __builtin_nontemporal_load(gp + 256), gc = __builtin_nontemporal_load(gp + 512), ba = __builtin_nontemporal_load(B0 + i), bb = __builtin_nontemporal_load(B1 + i), bc = S[i];
              const float y0 = sigmoidf_(bflo(ga.x)) * bflo(ba.x) + sigmoidf_(bflo(gb.x)) * bflo(bb.x) + sigmoidf_(bflo(gc.x)) * bflo(bc.x);
              const float y1 = sigmoidf_(bfhi(ga.x)) * bfhi(ba.x) + sigmoidf_(bfhi(gb.x)) * bfhi(bb.x) + sigmoidf_(bfhi(gc.x)) * bfhi(bc.x);
              const float y2 = sigmoidf_(bflo(ga.y)) * bflo(ba.y) + sigmoidf_(bflo(gb.y)) * bflo(bb.y) + sigmoidf_(bflo(gc.y)) * bflo(bc.y);
              const float y3 = sigmoidf_(bfhi(ga.y)) * bfhi(ba.y) + sigmoidf_(bfhi(gb.y)) * bfhi(bb.y) + sigmoidf_(bfhi(gc.y)) * bfhi(bc.y);
              u32x2 o; o.x = pk(y0, y1); o.y = pk(y2, y3); S[i] = o; }
          conv_job(P.ffn2_d + (size_t)l * DFF * DM, DFF, DM, (bf16*)(ws + WS_W + WA_D), DFF, DM, 0, nullptr, scr, gw, ngw, lane); }
        GSYNC();
        for (int rep = 0; rep < REP_WOUT; ++rep) { PHASE_VIEW(); run_gemm(lds, (const bf16*)(ws + WS_SG), (const bf16*)(wa + WA_OUT), MT, DM, DM, 0, EpiBf16{(bf16*)(ws + WS_YO), DM}); }
        { PHASE_VIEW(); CONV_VIEW(); if (cdo) conv_job(P.ffn2_gu + (size_t)l * DM * 2 * DFF, DM, 2 * DFF, (bf16*)(ws + WS_W + WA_GU), DM, 2 * DFF, 1, nullptr, scr, cgw, cngw, lane); }
        GSYNC();
        { PHASE_VIEW();
          row_phase(P, ws, 1, (const bf16*)(ws + WS_YO), l, 1, 1.0f, l, 2, false, gw, ngw, lane);
        }
        GSYNC();
        ffn_phases(P, xbar, lds, l == 0 ? 2 : 0, l);
        if (l == 0) {
            PHASE_VIEW();
            row_phase(P, ws, 1, (const bf16*)(ws + WS_YF), 0, 2, 0.5f, 1, 0, false, gw, ngw, lane);
            conv_job(P.ffn1_d + (size_t)DFF * DM, DFF, DM, (bf16*)(ws + WS_W + WA_D), DFF, DM, 0, nullptr, scr, gw, ngw, lane);
        } else {
            PHASE_VIEW();
            row_phase(P, ws, 2, (const bf16*)(ws + WS_YF), 1, 2, 0.5f, 0, 0, false, gw, ngw, lane);
        }
        if (l == 0) GSYNC();
    }
}

extern "C" void kernel_launch(void* const* d_in, const int* in_sizes, int n_in, void* d_out, int out_size, void* d_ws, size_t ws_size, hipStream_t stream) {
    static int grid_blocks = 0;
    if (!grid_blocks) {
        if (n_in != 27 || ws_size < WS_END) { fprintf(stderr, "kernel_launch: unexpected n_in %d or ws_size %zu (< %zu)\n", n_in, ws_size, (size_t)WS_END); grid_blocks = -1; return; }
        int dev = 0, cus = 0, per_cu = 0;
        (void)hipGetDevice(&dev);
        (void)hipDeviceGetAttribute(&cus, hipDeviceAttributeMultiprocessorCount, dev);
        if (hipFuncSetAttribute((const void*)fwd_kernel, hipFuncAttributeMaxDynamicSharedMemorySize, LDS_BYTES) != hipSuccess) fprintf(stderr, "kernel_launch: hipFuncSetAttribute failed\n");
        if (hipOccupancyMaxActiveBlocksPerMultiprocessor(&per_cu, (const void*)fwd_kernel, 512, LDS_BYTES) != hipSuccess || per_cu < 1) { per_cu = 1; (void)hipGetLastError(); }
        grid_blocks = cus * per_cu;
    }
    if (grid_blocks < 0) return;
    Params p{};
    const float** pp = (const float**)&p;
    for (int i = 0; i < 27; ++i) pp[i] = (const float*)d_in[i];
    p.out = (float*)d_out; p.ws = (unsigned char*)d_ws;
    (void)hipMemsetAsync((char*)d_ws + WS_BAR, 0, 16 * 1024, stream);
    void* args[] = {&p};
    hipError_t e = hipLaunchCooperativeKernel((const void*)fwd_kernel, dim3(grid_blocks), dim3(512), args, LDS_BYTES, stream);
    if (e != hipSuccess) fprintf(stderr, "cooperative launch failed: %s (grid %d)\n", hipGetErrorString(e), grid_blocks);
}
```

```cpp
#include <hip/hip_runtime.h>
#include <hip/hip_cooperative_groups.h>
#include <cstdio>
#include <cstdint>
namespace cg = cooperative_groups;
namespace pg8 {
#define PG8_LAS __attribute__((address_space(3)))
typedef unsigned short bf16_t;
typedef short bf16x8 __attribute__((ext_vector_type(8)));
typedef float f32x4 __attribute__((ext_vector_type(4)));
typedef unsigned u32x4 __attribute__((ext_vector_type(4)));
constexpr int BM = 256, BK = 64, HALF = 128, HTB = HALF * BK * 2  , STAGE_BYTES = 8 * HTB, NXCD = 8, WGM = 8;

__host__ __device__ __forceinline__ int lds_byte(int r, int c) { const int st = (r >> 4) * 2 + (c >> 5), rr = r & 15, cc = c & 31, ob = rr * 64 + cc * 2; return st * 1024 + (ob ^ (((ob >> 9) & 1) << 5)); }
__host__ __device__ __forceinline__ void stage_rc(int b, int& R, int& C) { const int st = b / 1024, sb = b % 1024, swz = sb ^ (((sb >> 9) & 1) << 5); R = (st >> 1) * 16 + swz / 64; C = (st & 1) * 32 + (swz % 64) / 2; }
__host__ __device__ __forceinline__ int perm32(int rho) { const int n = rho >> 4, i = rho & 15; return 8 * (i >> 2) + 4 * n + (i & 3); }

struct Unit { int pm, pn; };
struct Gemm { const bf16_t* A; const bf16_t* Bt; int M, N, K; };

struct StaticOrder {
    int nM, nN, nwg, G, c;
    __host__ __device__ void init(int M, int N, int G_, int c_) { nM = M / BM; nN = N / BM; nwg = nM * nN; G = G_; c = c_; }
    __host__ __device__ bool next(int i, Unit& u) const {
        const long L = (long)i * G + c; if (L >= nwg) return false;
        int wgid = (int)L; { const int q = nwg / NXCD, r = nwg % NXCD, xcd = wgid % NXCD, off = wgid / NXCD; wgid = (xcd < r ? xcd * (q + 1) : r * (q + 1) + (xcd - r) * q) + off; }
        const int nig = WGM * nN, gid = wgid / nig, fm = gid * WGM, gsz = (nM - fm) < WGM ? (nM - fm) : WGM;
        u.pm = fm + ((wgid % nig) % gsz); u.pn = (wgid % nig) / gsz; return true;
    }
    __device__ __forceinline__ void a_ready(const Unit&) const {}
    __device__ __forceinline__ void done(const Unit&) const {}
};
__device__ __forceinline__ unsigned cvt_pk_bf16(float lo, float hi) { unsigned r; asm volatile("v_cvt_pk_bf16_f32 %0, %1, %2" : "=v"(r) : "v"(lo), "v"(hi)); return r; }
template <class Epi, class Sched, bool ALIGN_EPI = false, bool SP2 = false>
__device__ __forceinline__ void gemm_phase(PG8_LAS unsigned char* lds, const Gemm g, const Sched& S, const Epi& E) {
    int tid_ = threadIdx.x; asm volatile("" : "+v"(tid_)); const int tid = tid_, wid = __builtin_amdgcn_readfirstlane(tid >> 6), lane = tid & 63, wr = wid >> 2, wc = wid & 3, fr = lane & 15, fq = lane >> 4;
    const int K = g.K, nt = K / BK;
    unsigned voffA[2], voffB[2];
#pragma unroll
    for (int i = 0; i < 2; ++i) { int R, C; stage_rc(tid * 16 + i * 8192, R, C); const int Rb = Epi::PERM ? ((R & ~31) + perm32(R & 31)) : R;
        voffA[i] = (unsigned)(R * K + C) * 2u; voffB[i] = (unsigned)(Rb * K + C) * 2u; }
    const size_t kstep = (size_t)(BK * 2);
    const size_t hstep = (size_t)HALF * K * 2;
    const size_t tstep = 2 * hstep;
    const unsigned ldsw = (unsigned)wid * 1024u;
    const int aoff = lds_byte(wr * 64 + fr, fq * 8), boff = lds_byte(wc * 32 + fr, fq * 8);
#define PG8_SA(b, h) (((b) * 2 + (h)) * HTB)
#define PG8_SB(b, h) ((4 + (b) * 2 + (h)) * HTB)
#define PG8_STAGE(bufoff, gbase, voff) do { _Pragma("unroll") for (int _i = 0; _i < 2; ++_i) \
        __builtin_amdgcn_global_load_lds((const unsigned*)((const char*)(gbase) + (voff)[_i]), (PG8_LAS unsigned*)(lds + (bufoff) + ldsw + _i * 8192), 16, 0, 0); } while (0)
#define PG8_LDA(dst, b, h) do { _Pragma("unroll") for (int m = 0; m < 4; ++m) _Pragma("unroll") for (int k = 0; k < 2; ++k) dst[m][k] = *(const PG8_LAS bf16x8*)(lds + PG8_SA(b, h) + aoff + m * 2048 + k * 1024); } while (0)
#define PG8_LDB(dst, b, h) do { _Pragma("unroll") for (int n = 0; n < 2; ++n) _Pragma("unroll") for (int k = 0; k < 2; ++k) dst[n][k] = *(const PG8_LAS bf16x8*)(lds + PG8_SB(b, h) + boff + n * 2048 + k * 1024); } while (0)
#define PG8_MMA(ai, bj, At, Bt) do { __builtin_amdgcn_s_setprio(1); _Pragma("unroll") for (int m = 0; m < 4; ++m) _Pragma("unroll") for (int n = 0; n < 2; ++n) _Pragma("unroll") for (int k = 0; k < 2; ++k) \
        acc[ai][bj][m][n] = __builtin_amdgcn_mfma_f32_16x16x32_bf16(Bt[n][k], At[m][k], acc[ai][bj][m][n], 0, 0, 0); __builtin_amdgcn_s_setprio(0); } while (0)
#define PG8_WAIT_V(n) asm volatile("s_waitcnt vmcnt(" #n ")" ::: "memory")
#define PG8_WAIT_L(n) asm volatile("s_waitcnt lgkmcnt(" #n ")" ::: "memory")
#define PG8_BAR __builtin_amdgcn_s_barrier()
#define PG8_SCHED __builtin_amdgcn_sched_barrier(0)
    Unit cur, nxt; int ui = 0;
    if (!S.next(0, cur)) return;
    f32x4 acc[2][2][4][2];
#pragma unroll
    for (int a = 0; a < 2; ++a)
#pragma unroll
        for (int b = 0; b < 2; ++b)
#pragma unroll
            for (int m = 0; m < 4; ++m)
#pragma unroll
                for (int n = 0; n < 2; ++n) acc[a][b][m][n] = (f32x4){0.f, 0.f, 0.f, 0.f};
    bf16x8 At[4][2], B0[2][2], B1[2][2];
    const char* cA = (const char*)g.A + (size_t)cur.pm * tstep; const char* cB = (const char*)g.Bt + (size_t)cur.pn * tstep;
    S.a_ready(cur);
    if constexpr (SP2) {
        PG8_STAGE(PG8_SB(0, 0), cB, voffB); PG8_STAGE(PG8_SB(0, 1), cB + hstep, voffB); PG8_STAGE(PG8_SA(0, 0), cA, voffA); PG8_STAGE(PG8_SA(0, 1), cA + hstep, voffA);
        if (wr == 1) PG8_BAR;
        PG8_WAIT_V(2); PG8_BAR;
        PG8_STAGE(PG8_SB(1, 0), cB + kstep, voffB); PG8_STAGE(PG8_SA(1, 0), cA + kstep, voffA); PG8_STAGE(PG8_SB(1, 1), cB + hstep + kstep, voffB);
        PG8_WAIT_V(6); PG8_BAR;
    } else {
        PG8_STAGE(PG8_SB(0, 0), cB, voffB); PG8_STAGE(PG8_SA(0, 0), cA, voffA); PG8_STAGE(PG8_SB(0, 1), cB + hstep, voffB); PG8_STAGE(PG8_SA(0, 1), cA + hstep, voffA);
        if (wr == 1) PG8_BAR;
        PG8_WAIT_V(4); PG8_BAR;
        PG8_STAGE(PG8_SB(1, 0), cB + kstep, voffB); PG8_STAGE(PG8_SA(1, 0), cA + kstep, voffA); PG8_STAGE(PG8_SB(1, 1), cB + hstep + kstep, voffB);
        PG8_WAIT_V(6); PG8_BAR;
    }
    for (;;) {
        const bool has_next = S.next(ui + 1, nxt);
        const char* nA = has_next ? (const char*)g.A + (size_t)nxt.pm * tstep : cA; const char* nB = has_next ? (const char*)g.Bt + (size_t)nxt.pn * tstep : cB;
#pragma unroll 1
        for (int t = 0; t < nt; t += 2) {
            const bool last = (t == nt - 2);
            const char* a1 = cA + (size_t)(t + 1) * kstep;
            const char* a2 = last ? nA : cA + (size_t)(t + 2) * kstep; const char* b2 = last ? nB : cB + (size_t)(t + 2) * kstep;
            const char* a3 = a2 + kstep; const char* b3 = b2 + kstep;
            if (last && has_next) S.a_ready(nxt);
            if constexpr (SP2) {
            PG8_LDB(B0, 0, 0); PG8_LDB(B1, 0, 1); PG8_SCHED; PG8_LDA(At, 0, 0); PG8_STAGE(PG8_SA(1, 1), a1 + hstep, voffA);
            PG8_WAIT_V(8); PG8_WAIT_L(0); PG8_BAR; PG8_MMA(0, 0, At, B0); PG8_MMA(0, 1, At, B1); PG8_BAR; PG8_SCHED;
            PG8_LDA(At, 0, 1); PG8_STAGE(PG8_SB(0, 0), b2, voffB); PG8_STAGE(PG8_SB(0, 1), b2 + hstep, voffB); PG8_STAGE(PG8_SA(0, 0), a2, voffA);
            PG8_WAIT_V(8); PG8_WAIT_L(0); PG8_BAR; PG8_MMA(1, 0, At, B0); PG8_MMA(1, 1, At, B1); PG8_BAR; PG8_SCHED;
            PG8_LDB(B0, 1, 0); PG8_LDB(B1, 1, 1); PG8_SCHED; PG8_LDA(At, 1, 0); PG8_STAGE(PG8_SA(0, 1), a2 + hstep, voffA);
            PG8_WAIT_V(8); PG8_WAIT_L(0); PG8_BAR; PG8_MMA(0, 0, At, B0); PG8_MMA(0, 1, At, B1); PG8_BAR; PG8_SCHED;
            PG8_LDA(At, 1, 1); PG8_STAGE(PG8_SB(1, 0), b3, voffB); PG8_STAGE(PG8_SB(1, 1), b3 + hstep, voffB); PG8_STAGE(PG8_SA(1, 0), a3, voffA);
            PG8_WAIT_V(8); PG8_WAIT_L(0); PG8_BAR; PG8_MMA(1, 0, At, B0); PG8_MMA(1, 1, At, B1); PG8_BAR; PG8_SCHED;
            } else {
            PG8_LDB(B0, 0, 0); PG8_SCHED; PG8_LDA(At, 0, 0); PG8_STAGE(PG8_SA(1, 1), a1 + hstep, voffA);
            PG8_WAIT_L(8); PG8_BAR; PG8_WAIT_L(0); PG8_MMA(0, 0, At, B0); PG8_BAR; PG8_SCHED;
            PG8_LDB(B1, 0, 1); PG8_STAGE(PG8_SB(0, 0), b2, voffB);
            PG8_BAR; PG8_WAIT_L(0); PG8_MMA(0, 1, At, B1); PG8_BAR;
            PG8_LDA(At, 0, 1); PG8_STAGE(PG8_SA(0, 0), a2, voffA);
            PG8_BAR; PG8_WAIT_L(0); PG8_MMA(1, 0, At, B0); PG8_BAR; PG8_SCHED;
            PG8_STAGE(PG8_SB(0, 1), b2 + hstep, voffB);
            PG8_WAIT_V(6); PG8_BAR; PG8_MMA(1, 1, At, B1); PG8_BAR;
            PG8_LDB(B0, 1, 0); PG8_SCHED; PG8_LDA(At, 1, 0); PG8_STAGE(PG8_SA(0, 1), a2 + hstep, voffA);
            PG8_WAIT_L(8); PG8_BAR; PG8_WAIT_L(0); PG8_MMA(0, 0, At, B0); PG8_BAR; PG8_SCHED;
            PG8_LDB(B1, 1, 1); PG8_STAGE(PG8_SB(1, 0), b3, voffB);
            PG8_BAR; PG8_WAIT_L(0); PG8_MMA(0, 1, At, B1); PG8_BAR;
            PG8_LDA(At, 1, 1); PG8_STAGE(PG8_SA(1, 0), a3, voffA);
            PG8_BAR; PG8_WAIT_L(0); PG8_MMA(1, 0, At, B0); PG8_BAR; PG8_SCHED;
            PG8_STAGE(PG8_SB(1, 1), b3 + hstep, voffB);
            PG8_WAIT_V(6); PG8_BAR; PG8_MMA(1, 1, At, B1); PG8_BAR;
            }
        }
        if constexpr (ALIGN_EPI) { if (wr == 0) PG8_BAR; }
        if constexpr (!Epi::AFTER_DRAIN) { E(acc, cur, wr, wc, fr, fq); S.done(cur); }
        if (!has_next) break;
#pragma unroll
        for (int a = 0; a < 2; ++a)
#pragma unroll
            for (int b = 0; b < 2; ++b)
#pragma unroll
                for (int m = 0; m < 4; ++m)
#pragma unroll
                    for (int n = 0; n < 2; ++n) acc[a][b][m][n] = (f32x4){0.f, 0.f, 0.f, 0.f};
        cur = nxt; cA = nA; cB = nB; ++ui;
        if constexpr (ALIGN_EPI) { if (wr == 1) PG8_BAR; }
    }
    PG8_WAIT_V(0);
    if constexpr (!ALIGN_EPI) { if (wr == 0) PG8_BAR; }
    PG8_BAR;
    if constexpr (Epi::AFTER_DRAIN) { E.fused(acc, cur, wr, wc, fr, fq, lds, wid, lane); S.done(cur); }
#undef PG8_SA
#undef PG8_SB
#undef PG8_STAGE
#undef PG8_LDA
#undef PG8_LDB
#undef PG8_MMA
#undef PG8_WAIT_V
#undef PG8_WAIT_L
#undef PG8_BAR
#undef PG8_SCHED
}
}

#define LAS __attribute__((address_space(3)))
typedef unsigned short bf16;
using pg8::f32x4; using pg8::bf16x8; using pg8::u32x4; using pg8::Unit;
typedef unsigned u32x2 __attribute__((ext_vector_type(2)));
typedef float f32x2 __attribute__((ext_vector_type(2)));

constexpr int DM = 1024, MC = 4096, ML = 16384, MT = 20480, DFF = 2816;
constexpr float EPS = 1e-6f;
constexpr float LOG2E = 1.4426950408889634f;
constexpr float QSCALE = 0.10206207261596577f * 1.4426950408889634f;
constexpr size_t MiB = 1u << 20;
constexpr size_t WS_MOD = 0;
constexpr size_t WS_SSQ = 512 * 1024;
constexpr size_t WS_ROPE8 = 1 * MiB;
constexpr size_t WS_ROPE64 = 2 * MiB;
constexpr size_t WS_KVF32 = 4 * MiB;
constexpr size_t WS_CACHEA = 6 * MiB;
constexpr size_t WS_W = 7 * MiB;
constexpr size_t WS_H = 27 * MiB;
constexpr size_t WS_ACT = 67 * MiB;
constexpr size_t WS_YF = 177 * MiB;
constexpr size_t WS_QKC = 67 * MiB;
constexpr size_t WS_RGS = 87 * MiB;
constexpr size_t WS_YPOOL = 107 * MiB;
constexpr size_t WS_PU = 127 * MiB;
constexpr size_t WS_RQ = 147 * MiB, WS_RK = 167 * MiB, WS_RV = 187 * MiB;
constexpr size_t WS_Q = 207 * MiB;
constexpr size_t WS_K = 237 * MiB;
constexpr size_t WS_VT = 270 * MiB;
constexpr size_t WS_ULAT = 292 * MiB;
constexpr size_t WS_UCTX = 324 * MiB;
constexpr size_t WS_SCTX = 340 * MiB;
constexpr size_t WS_GF = 127 * MiB, WS_BF = 167 * MiB, WS_SG = 287 * MiB;
constexpr size_t WS_BF2 = 247 * MiB;
constexpr size_t WS_GATE = 127 * MiB;
constexpr size_t WS_YM = 247 * MiB;
constexpr size_t WS_YO = 127 * MiB;
constexpr size_t WS_END = 348 * MiB;
constexpr size_t WA_GU = 0, WA_D = 12 * MiB;
constexpr size_t WA_INB = 0, WA_ING = 6 * MiB, WA_UQ = 12 * MiB, WA_KF = 12 * MiB + 512 * 1024, WA_KP = 12 * MiB + 768 * 1024,
                 WA_VF = 13 * MiB, WA_VP = 13 * MiB + 256 * 1024, WA_BA = 14 * MiB, WA_BR = 15 * MiB, WA_EFF = 16 * MiB, WA_OUT = 18 * MiB;
constexpr size_t K_CTX_ROWS = 16 * 8 * 256, V_CTX_ROWS = 16 * 8 * 64;
constexpr int OUT_CKV = MT * DM, OUT_KR = OUT_CKV + 16 * 2 * 256 * 128, OUT_ST = OUT_KR + 16 * 2 * 256 * 32;

struct Params {
    const float *x_prompt, *x_sample, *cache_ckv, *cache_kr, *state_ret, *c, *c_ctx, *w_ada, *b_ada, *norm_pre, *norm_post,
        *ffn1_gu, *ffn1_d, *ffn2_gu, *ffn2_d, *w_in, *q_norm, *w_uq, *kv_norm, *w_ukv, *ret_decay, *pool_w, *pool_scale, *w_ba, *w_br, *w_bp, *w_out;
    float* out; unsigned char* ws;
};

__device__ __forceinline__ unsigned pk(float lo, float hi) { return pg8::cvt_pk_bf16(lo, hi); }
__device__ __forceinline__ float bf2f(unsigned short b) { return __uint_as_float((unsigned)b << 16); }
__device__ __forceinline__ float bflo(unsigned w) { return __uint_as_float(w << 16); }
__device__ __forceinline__ float bfhi(unsigned w) { return __uint_as_float(w & 0xffff0000u); }
__device__ __forceinline__ u32x4 pack8(const f32x4 a, const f32x4 b) { u32x4 w; w.x = pk(a[0], a[1]); w.y = pk(a[2], a[3]); w.z = pk(b[0], b[1]); w.w = pk(b[2], b[3]); return w; }
__device__ __forceinline__ float fast_exp2(float x) { return __builtin_amdgcn_exp2f(x); }
__device__ __forceinline__ float sigmoidf_(float x) { return __builtin_amdgcn_rcpf(1.0f + fast_exp2(-x * LOG2E)); }
__device__ __forceinline__ float siluf_(float x) { return x * sigmoidf_(x); }
__device__ __forceinline__ float wave_sum(float v) {
#pragma unroll
    for (int o = 1; o < 64; o <<= 1) v += __shfl_xor(v, o);
    return v;
}
__device__ __forceinline__ f32x4 rope4(const f32x4 v, const float2 a, const float2 b) {
    f32x4 o; o[0] = v[0] * a.x - v[1] * a.y; o[1] = v[0] * a.y + v[1] * a.x; o[2] = v[2] * b.x - v[3] * b.y; o[3] = v[2] * b.y + v[3] * b.x; return o;
}

#define EPI_ROW(u, ai, m) ((u).pm * 256 + (ai) * 128 + wr * 64 + (m) * 16 + fr)
#define EPI_COL(bj) ((bj) * 128 + wc * 32 + 8 * fq)

struct EpiGU {
    static constexpr bool PERM = true, AFTER_DRAIN = false;
    bf16* act;
    __device__ __forceinline__ void operator()(const f32x4 (&acc)[2][2][4][2], const Unit& u, int wr, int wc, int fr, int fq) const {
#pragma unroll
        for (int ai = 0; ai < 2; ++ai)
#pragma unroll
            for (int m = 0; m < 4; ++m) {
                const int row = EPI_ROW(u, ai, m);
                f32x4 o0, o1;
#pragma unroll
                for (int i = 0; i < 4; ++i) { o0[i] = siluf_(acc[ai][0][m][0][i]) * acc[ai][1][m][0][i]; o1[i] = siluf_(acc[ai][0][m][1][i]) * acc[ai][1][m][1][i]; }
                *(u32x4*)(act + (size_t)row * DFF + u.pn * 128 + wc * 32 + 8 * fq) = pack8(o0, o1);
            }
    }
};
struct EpiF32 {
    static constexpr bool PERM = true, AFTER_DRAIN = false;
    float* out; int ld;
    __device__ __forceinline__ void operator()(const f32x4 (&acc)[2][2][4][2], const Unit& u, int wr, int wc, int fr, int fq) const {
#pragma unroll
        for (int ai = 0; ai < 2; ++ai)
#pragma unroll
            for (int m = 0; m < 4; ++m) {
                float* rp = out + (size_t)EPI_ROW(u, ai, m) * ld + u.pn * 256;
#pragma unroll
                for (int bj = 0; bj < 2; ++bj) { *(f32x4*)(rp + EPI_COL(bj)) = acc[ai][bj][m][0]; *(f32x4*)(rp + EPI_COL(bj) + 4) = acc[ai][bj][m][1]; }
            }
    }
};
struct EpiBf16 {
    static constexpr bool PERM = true, AFTER_DRAIN = false;
    bf16* out; int ld;
    __device__ __forceinline__ void operator()(const f32x4 (&acc)[2][2][4][2], const Unit& u, int wr, int wc, int fr, int fq) const {
        asm volatile("" : "+v"(fr), "+v"(fq));
#pragma unroll
        for (int ai = 0; ai < 2; ++ai)
#pragma unroll
            for (int m = 0; m < 4; ++m) {
                bf16* rp = out + (size_t)EPI_ROW(u, ai, m) * ld + u.pn * 256;
#pragma unroll
                for (int bj = 0; bj < 2; ++bj) *(u32x4*)(rp + EPI_COL(bj)) = pack8(acc[ai][bj][m][0], acc[ai][bj][m][1]);
                asm volatile("" ::: "memory");
            }
    }
};
struct EpiGate {
    static constexpr bool PERM = true, AFTER_DRAIN = false;
    bf16* out;
    __device__ __forceinline__ void operator()(const f32x4 (&acc)[2][2][4][2], const Unit& u, int wr, int wc, int fr, int fq) const {
#pragma unroll
        for (int ai = 0; ai < 2; ++ai)
#pragma unroll
            for (int m = 0; m < 4; ++m) {
                bf16* rp = out + (size_t)EPI_ROW(u, ai, m) * DM + u.pn * 256;
#pragma unroll
                for (int bj = 0; bj < 2; ++bj) { f32x4 a = acc[ai][bj][m][0], b = acc[ai][bj][m][1];
#pragma unroll
                    for (int i = 0; i < 4; ++i) { a[i] = sigmoidf_(a[i]); b[i] = sigmoidf_(b[i]); }
                    *(u32x4*)(rp + EPI_COL(bj)) = pack8(a, b); }
            }
    }
};
template <int MODE> struct EpiMerge {
    static constexpr bool PERM = true, AFTER_DRAIN = false;
    bf16* gate; float* ym; bf16* outb;
    __device__ __forceinline__ void operator()(const f32x4 (&acc)[2][2][4][2], const Unit& u, int wr, int wc, int fr, int fq) const {
#pragma unroll
        for (int ai = 0; ai < 2; ++ai)
#pragma unroll
            for (int m = 0; m < 4; ++m) {
                const size_t ro = (size_t)EPI_ROW(u, ai, m) * DM + u.pn * 256;
#pragma unroll
                for (int bj = 0; bj < 2; ++bj) {
                    const u32x4 g = *(const u32x4*)(gate + ro + EPI_COL(bj));
                    f32x4 a = acc[ai][bj][m][0], b = acc[ai][bj][m][1];
                    a[0] *= bflo(g.x); a[1] *= bfhi(g.x); a[2] *= bflo(g.y); a[3] *= bfhi(g.y);
                    b[0] *= bflo(g.z); b[1] *= bfhi(g.z); b[2] *= bflo(g.w); b[3] *= bfhi(g.w);
                    float* yp = ym + ro + EPI_COL(bj);
                    if (MODE >= 1) { a += *(const f32x4*)yp; b += *(const f32x4*)(yp + 4); }
                    if (MODE <= 1) { *(f32x4*)yp = a; *(f32x4*)(yp + 4) = b; }
                    else *(u32x4*)(outb + ro + EPI_COL(bj)) = pack8(a, b);
                }
            }
    }
};

struct EpiWinB {
    static constexpr bool PERM = true, AFTER_DRAIN = false;
    unsigned char* ws; float* out; int layer;
    __device__ __forceinline__ void operator()(const f32x4 (&acc)[2][2][4][2], const Unit& u, int wr, int wc, int fr, int fq) const {
        int t = u.pn; asm volatile("" : "+s"(t)); const bool lat = u.pm >= 16;
        asm volatile("" : "+v"(fr), "+v"(fq));
        bf16* const qkc = (bf16*)(ws + WS_QKC); bf16* const Kctx = (bf16*)(ws + WS_K); bf16* const Klat = Kctx + K_CTX_ROWS * 96;
        float* const ssq_q = (float*)(ws + WS_SSQ) + (size_t)layer * 2 * MT; float* const ssq_kv = ssq_q + MT; float* const kvf32 = (float*)(ws + WS_KVF32); float* const out_kr = out + OUT_KR;
        const float2* const rope64 = (const float2*)(ws + WS_ROPE64); const float2* const rope8 = (const float2*)(ws + WS_ROPE8);
        if (t == 0) {
#pragma unroll
            for (int ai = 0; ai < 2; ++ai)
#pragma unroll
                for (int m = 0; m < 4; ++m) {
                    const int row = EPI_ROW(u, ai, m); float ss = 0.f;
#pragma unroll
                    for (int bj = 0; bj < 2; ++bj) { const f32x4 a = acc[ai][bj][m][0], b = acc[ai][bj][m][1];
                        ss += (a[0] * a[0] + a[1] * a[1]) + (a[2] * a[2] + a[3] * a[3]) + (b[0] * b[0] + b[1] * b[1]) + (b[2] * b[2] + b[3] * b[3]);
                        *(u32x4*)(qkc + (size_t)row * 256 + EPI_COL(bj)) = pack8(a, b); }
                    ss += __shfl_xor(ss, 16); ss += __shfl_xor(ss, 32);
                    if (fq == 0) atomicAdd(ssq_q + row, ss);
                    asm volatile("" ::: "memory");
                }
        } else if (t == 1) {
#pragma unroll
            for (int ai = 0; ai < 2; ++ai)
#pragma unroll
                for (int m = 0; m < 4; ++m) {
                    const int row = EPI_ROW(u, ai, m);
                    bf16* kvc = qkc + (size_t)MT * 256 + (size_t)row * 256;
                    { const f32x4 a = acc[ai][0][m][0], b = acc[ai][0][m][1];
                      float ss = (a[0] * a[0] + a[1] * a[1]) + (a[2] * a[2] + a[3] * a[3]) + (b[0] * b[0] + b[1] * b[1]) + (b[2] * b[2] + b[3] * b[3]);
                      *(u32x4*)(kvc + EPI_COL(0)) = pack8(a, b);
                      if (!lat) { float* kf = kvf32 + (size_t)row * 128 + wc * 32 + 8 * fq; *(f32x4*)kf = a; *(f32x4*)(kf + 4) = b; }
                      ss += __shfl_xor(ss, 16); ss += __shfl_xor(ss, 32);
                      if (fq == 0) atomicAdd(ssq_kv + row, ss); }
                    f32x4 a = acc[ai][1][m][0], b = acc[ai][1][m][1];
                    *(u32x4*)(kvc + EPI_COL(1)) = pack8(a, b);
                    if (wc == 0) {
                        const int part = fq >> 1, jb = (fq & 1) * 4;
                        if (lat) {
                            const int ml = row - MC, tt = ml & 4095, pos = part == 0 ? (tt >> 6) : (tt & 63);
                            const float2* cs = rope8 + pos * 8 + jb;
                            a = rope4(a, cs[0], cs[1]); b = rope4(b, cs[2], cs[3]);
                            const u32x4 w = pack8(a, b);
                            bf16* kp = Klat + ((size_t)((ml >> 12) * 8) * 4608 + (ml & 4095)) * 96 + 64 + 8 * fq;
#pragma unroll
                            for (int h = 0; h < 8; ++h) *(u32x4*)(kp + (size_t)h * 4608 * 96) = w;
                        } else {
                            const u32x4 w = pack8(a, b);
                            bf16* kp = Kctx + ((size_t)((row >> 8) * 8) * 256 + (row & 255)) * 96 + 64 + 8 * fq;
#pragma unroll
                            for (int h = 0; h < 8; ++h) *(u32x4*)(kp + (size_t)h * 256 * 96) = w;
                            float* op = out_kr + ((size_t)((row >> 8) * 2 + layer) * 256 + (row & 255)) * 32 + 16 * part + jb;
                            *(f32x4*)op = (f32x4){a[0], a[2], b[0], b[2]}; *(f32x4*)(op + 8) = (f32x4){a[1], a[3], b[1], b[3]};
                        }
                    }
                    asm volatile("" ::: "memory");
                }
        } else if (t < 6) {
            bf16* dst = (bf16*)(ws + (t < 4 ? WS_RQ : WS_RK)); const float sc = t < 4 ? 1.0f : 0.08838834764831845f;
            const int i0 = 16 * wc + 4 * fq;
#pragma unroll
            for (int ai = 0; ai < 2; ++ai)
#pragma unroll
                for (int m = 0; m < 4; ++m) {
                    const int row = EPI_ROW(u, ai, m);
                    const float2* cs = rope64 + (size_t)((row - MC) & 4095) * 64 + i0;
#pragma unroll
                    for (int bj = 0; bj < 2; ++bj) {
                        f32x4 a = acc[ai][bj][m][0] * sc, b = acc[ai][bj][m][1] * sc;
                        if (lat) { a = rope4(a, cs[0], cs[1]); b = rope4(b, cs[2], cs[3]); }
                        *(u32x4*)(dst + (size_t)row * 512 + (t & 1) * 256 + EPI_COL(bj)) = pack8(a, b);
                    }
                    asm volatile("" ::: "memory");
                }
        } else {
            bf16* dst = (bf16*)(ws + (t < 8 ? WS_RV : (t < 10 ? WS_RGS : WS_PU)));
#pragma unroll
            for (int ai = 0; ai < 2; ++ai)
#pragma unroll
                for (int m = 0; m < 4; ++m) {
                    const int row = EPI_ROW(u, ai, m);
#pragma unroll
                    for (int bj = 0; bj < 2; ++bj) {
                        f32x4 a = acc[ai][bj][m][0], b = acc[ai][bj][m][1];
                        if (t == 8 || t == 9) {
#pragma unroll
                            for (int i = 0; i < 4; ++i) { a[i] = siluf_(a[i]); b[i] = siluf_(b[i]); } }
                        *(u32x4*)(dst + (size_t)row * 512 + (t & 1) * 256 + EPI_COL(bj)) = pack8(a, b);
                    }
                    asm volatile("" ::: "memory");
                }
        }
    }
};

struct EpiQ {
    static constexpr bool PERM = true, AFTER_DRAIN = false;
    bf16* Q; const float* ssq; const float2* rope8;
    __device__ __forceinline__ void operator()(const f32x4 (&acc)[2][2][4][2], const Unit& u, int wr, int wc, int fr, int fq) const {
        const bool lat = u.pm >= 16;
#pragma unroll
        for (int ai = 0; ai < 2; ++ai)
#pragma unroll
            for (int m = 0; m < 4; ++m) {
                const int row = EPI_ROW(u, ai, m);
                const float rs = rsqrtf(ssq[row] * (1.0f / 256.0f) + EPS) * QSCALE;
                const int tt = (row - MC) & 4095;
#pragma unroll
                for (int bj = 0; bj < 2; ++bj) {
                    const int gb = u.pn * 256 + bj * 128 + wc * 32;
                    f32x4 a = acc[ai][bj][m][0] * rs, b = acc[ai][bj][m][1] * rs;
                    if (lat && (gb % 96) == 64) {
                        const int part = fq >> 1, jb = (fq & 1) * 4, pos = part == 0 ? (tt >> 6) : (tt & 63);
                        const float2* cs = rope8 + pos * 8 + jb;
                        a = rope4(a, cs[0], cs[1]); b = rope4(b, cs[2], cs[3]);
                    }
                    *(u32x4*)(Q + (size_t)row * 768 + gb + 8 * fq) = pack8(a, b);
                }
                asm volatile("" ::: "memory");
            }
    }
};
struct EpiK {
    static constexpr bool PERM = true, AFTER_DRAIN = false;
    bf16 *Kctx, *Klat; const float* ssq; int cache;
    __device__ __forceinline__ void operator()(const f32x4 (&acc)[2][2][4][2], const Unit& u, int wr, int wc, int fr, int fq) const {
#pragma unroll
        for (int ai = 0; ai < 2; ++ai)
#pragma unroll
            for (int m = 0; m < 4; ++m) {
                const int row = EPI_ROW(u, ai, m);
                float rs = 1.0f; bf16* base; size_t nk, kb, key;
                if (cache) { base = Klat; nk = 4608; kb = row >> 9; key = 4096 + (row & 511); }
                else { rs = rsqrtf(ssq[row] * (1.0f / 128.0f) + EPS);
                    if (row < MC) { base = Kctx; nk = 256; kb = row >> 8; key = row & 255; }
                    else { base = Klat; nk = 4608; kb = (row - MC) >> 12; key = (row - MC) & 4095; } }
#pragma unroll
                for (int bj = 0; bj < 2; ++bj) {
                    const int c = u.pn * 256 + EPI_COL(bj), h = c >> 6, d = c & 63;
                    *(u32x4*)(base + ((kb * 8 + h) * nk + key) * 96 + d) = pack8(acc[ai][bj][m][0] * rs, acc[ai][bj][m][1] * rs);
                }
                asm volatile("" ::: "memory");
            }
    }
};
struct EpiVt {
    static constexpr bool PERM = true, AFTER_DRAIN = false;
    bf16 *Vctx, *Vlat; const float* ssq; int cache;
    __device__ __forceinline__ void operator()(const f32x4 (&acc)[2][2][4][2], const Unit& u, int wr, int wc, int fr, int fq) const {
#pragma unroll
        for (int bj = 0; bj < 2; ++bj) {
            const int tok = u.pn * 256 + EPI_COL(bj);
            f32x4 r0 = {1.f, 1.f, 1.f, 1.f}, r1 = r0; bf16* base; size_t nk, kb, key;
            if (cache) { base = Vlat; nk = 4608; kb = tok >> 9; key = 4096 + (tok & 511); }
            else { const f32x4 s0 = *(const f32x4*)(ssq + tok), s1 = *(const f32x4*)(ssq + tok + 4);
#pragma unroll
                for (int i = 0; i < 4; ++i) { r0[i] = rsqrtf(s0[i] * (1.0f / 128.0f) + EPS); r1[i] = rsqrtf(s1[i] * (1.0f / 128.0f) + EPS); }
                if (tok < MC) { base = Vctx; nk = 256; kb = tok >> 8; key = tok & 255; }
                else { base = Vlat; nk = 4608; kb = (tok - MC) >> 12; key = (tok - MC) & 4095; } }
#pragma unroll
            for (int ai = 0; ai < 2; ++ai)
#pragma unroll
                for (int m = 0; m < 4; ++m) {
                    const int f = EPI_ROW(u, ai, m), h = f >> 6, e = f & 63;
                    *(u32x4*)(base + ((kb * 8 + h) * 64 + e) * nk + key) = pack8(acc[ai][bj][m][0] * r0, acc[ai][bj][m][1] * r1);
                    asm volatile("" ::: "memory");
                }
        }
    }
};

__device__ __forceinline__ int kr_logical(int c) { return (c & 16) + ((c & 1) << 3) + ((c & 15) >> 1); }
__device__ __forceinline__ int src_col(int kind, int n) {
    switch (kind) {
    case 1: { const int pn = n >> 8, r = n & 255; return r < 128 ? pn * 128 + r : DFF + pn * 128 + (r - 128); }
    case 2: { const int t = n >> 8, r = n & 255;
        if (t == 0) return 3072 + r;
        if (t == 1) { if (r < 128) return 3328 + r; if (r < 160) return 3456 + kr_logical(r - 128); return -1; }
        if (t < 6) { const int base = t < 4 ? 3488 : 4000, head = ((t & 1) << 1) + (r >> 7), p = r & 127; return base + head * 128 + (p >> 1) + ((p & 1) << 6); }
        return 2976 + n; }
    case 4: { const int head = n / 96, cw = n - head * 96; return cw < 64 ? n : head * 96 + 64 + kr_logical(cw - 64); }
    case 5: return (n >> 6) * 128 + (n & 63);
    case 6: return (n >> 6) * 128 + 64 + (n & 63);
    default: return n;
    }
}
__device__ __forceinline__ void conv_job(const float* W, int Ksrc, int Nsrc, bf16* dst, int Kdst, int Nd, int kind, const float* gain, LAS float* scr, int gw, int ngw, int lane) {
    const int nblk = Nd >> 5, items = (Kdst >> 6) * nblk;
    const bool vec = (kind == 0 || kind == 1 || kind == 5 || kind == 6) && ((Nsrc & 3) == 0);
    for (int it = gw; it < items; it += ngw) {
        const int kb = it / nblk, nb = it - kb * nblk, k0 = kb << 6, n0 = nb << 5;
        if (vec) {
            const int n4 = (lane & 7) * 4, sc = src_col(kind, n0 + n4);
#pragma unroll
            for (int i = 0; i < 8; ++i) { const int kk = 8 * i + (lane >> 3), k = k0 + kk; f32x4 v = {0.f, 0.f, 0.f, 0.f};
                if (k < Ksrc) { v = *(const f32x4*)(W + (size_t)k * Nsrc + sc); if (gain) v *= gain[k]; }
                scr[kk * 33 + n4] = v[0]; scr[kk * 33 + n4 + 1] = v[1]; scr[kk * 33 + n4 + 2] = v[2]; scr[kk * 33 + n4 + 3] = v[3]; }
        } else {
            const int sc = src_col(kind, n0 + (lane & 31));
#pragma unroll 8
            for (int i = 0; i < 32; ++i) { const int kk = 2 * i + (lane >> 5), k = k0 + kk; float v = 0.f;
                if (sc >= 0 && k < Ksrc) { v = W[(size_t)k * Nsrc + sc]; if (gain) v *= gain[k]; }
                scr[kk * 33 + (lane & 31)] = v; }
        }
        asm volatile("s_waitcnt lgkmcnt(0)" ::: "memory");
        const int c = lane & 7;
#pragma unroll
        for (int j = 0; j < 4; ++j) { const int n = (lane >> 3) + 8 * j; const LAS float* s = scr + (8 * c) * 33 + n;
            u32x4 o; o.x = pk(s[0], s[33]); o.y = pk(s[66], s[99]); o.z = pk(s[132], s[165]); o.w = pk(s[198], s[231]);
            *(u32x4*)(dst + (size_t)(n0 + n) * Kdst + k0 + 8 * c) = o; }
        asm volatile("s_waitcnt lgkmcnt(0)" ::: "memory");
    }
}
__device__ __forceinline__ void conv_ffn(const float* gu, const float* dn, unsigned char* ws, LAS float* scr, int gw, int ngw, int lane) {
    conv_job(gu, DM, 2 * DFF, (bf16*)(ws + WS_W + WA_GU), DM, 2 * DFF, 1, nullptr, scr, gw, ngw, lane);
    conv_job(dn, DFF, DM, (bf16*)(ws + WS_W + WA_D), DFF, DM, 0, nullptr, scr, gw, ngw, lane);
}
__device__ __forceinline__ void conv_win(const Params& P, unsigned char* ws, int l, LAS float* scr, int gw, int ngw, int lane) {
    unsigned char* wa = ws + WS_W; const float* win = P.w_in + (size_t)l * DM * 6048;
    conv_job(win, DM, 6048, (bf16*)(wa + WA_INB), DM, 3072, 2, nullptr, scr, gw, ngw, lane);
    conv_job(win, DM, 6048, (bf16*)(wa + WA_ING), DM, 3072, 0, nullptr, scr, gw, ngw, lane);
}
__device__ __forceinline__ void conv_mixer(const Params& P, unsigned char* ws, int l, LAS float* scr, int gw, int ngw, int lane, int gtid, int gthreads) {
    unsigned char* wa = ws + WS_W;
    conv_job(P.w_uq + (size_t)l * 256 * 768, 256, 768, (bf16*)(wa + WA_UQ), 256, 768, 4, P.q_norm + l * 256, scr, gw, ngw, lane);
    const float* wukv = P.w_ukv + (size_t)l * 128 * 1024;
    conv_job(wukv, 128, 1024, (bf16*)(wa + WA_KF), 256, 512, 5, P.kv_norm + l * 128, scr, gw, ngw, lane);
    conv_job(wukv, 128, 1024, (bf16*)(wa + WA_KP), 256, 512, 5, nullptr, scr, gw, ngw, lane);
    conv_job(wukv, 128, 1024, (bf16*)(wa + WA_VF), 256, 512, 6, P.kv_norm + l * 128, scr, gw, ngw, lane);
    conv_job(wukv, 128, 1024, (bf16*)(wa + WA_VP), 256, 512, 6, nullptr, scr, gw, ngw, lane);
    conv_job(P.w_ba + (size_t)l * 512 * DM, 512, DM, (bf16*)(wa + WA_BA), 512, DM, 0, nullptr, scr, gw, ngw, lane);
    conv_job(P.w_br + (size_t)l * 512 * DM, 512, DM, (bf16*)(wa + WA_BR), 512, DM, 0, nullptr, scr, gw, ngw, lane);
    conv_job(P.w_out + (size_t)l * DM * DM, DM, DM, (bf16*)(wa + WA_OUT), DM, DM, 0, nullptr, scr, gw, ngw, lane);
    const float* pw = P.pool_w + (size_t)l * 4 * 128 * 128; const float* ps = P.pool_scale + l * 512; const float* wp = P.w_bp + (size_t)l * 512 * DM;
    bf16* weff = (bf16*)(wa + WA_EFF);
    for (int it = gtid; it < DM * 64; it += gthreads) {
        const int n = it & 1023, k8 = (it >> 10) * 8, g = k8 >> 7;
        float a[8] = {0.f, 0.f, 0.f, 0.f, 0.f, 0.f, 0.f, 0.f};
#pragma unroll 8
        for (int d = 0; d < 128; ++d) { const float w = ps[g * 128 + d] * wp[(size_t)(g * 128 + d) * DM + n];
#pragma unroll
            for (int j = 0; j < 8; ++j) a[j] += pw[(size_t)(k8 + j) * 128 + d] * w; }
        u32x4 o; o.x = pk(a[0], a[1]); o.y = pk(a[2], a[3]); o.z = pk(a[4], a[5]); o.w = pk(a[6], a[7]);
        *(u32x4*)(weff + (size_t)n * 512 + k8) = o;
    }
    bf16* ca = (bf16*)(ws + WS_CACHEA);
    for (int it = gtid; it < 2048 * 32; it += gthreads) {
        const int j = it >> 5, k8 = (it & 31) * 8; u32x4 o = {0u, 0u, 0u, 0u};
        if (k8 < 128) { const float* s = P.cache_ckv + ((size_t)((j >> 9) * 2 + l) * 512 + (j & 511)) * 128 + k8; const f32x4 a = *(const f32x4*)s, b = *(const f32x4*)(s + 4); o = pack8(a, b); }
        *(u32x4*)(ca + (size_t)j * 256 + k8) = o;
    }
}

__device__ __forceinline__ void mod_phase(const Params& P, unsigned char* ws, LAS float* lds, int tid, int wave, int lane) {
    LAS float* sc = lds; LAS float* red = lds + 5 * 1024;
    for (int i = tid; i < 5 * 1024; i += 512) { const int g = i >> 10, k = i & 1023; const float v = g == 0 ? P.c_ctx[k] : P.c[(g - 1) * 1024 + k]; sc[i] = v / (1.0f + expf(-v)); }
    __syncthreads();
    float* mod = (float*)(ws + WS_MOD);
    for (int item = blockIdx.x; item < 288; item += gridDim.x) {
        const int l = item / 144, cb = item - l * 144;
        const float* Wp = P.w_ada + (size_t)l * DM * 9216 + cb * 64 + lane;
        float a0 = 0.f, a1 = 0.f, a2 = 0.f, a3 = 0.f, a4 = 0.f;
#pragma unroll 8
        for (int k = wave * 128; k < wave * 128 + 128; ++k) { const float w = Wp[(size_t)k * 9216];
            a0 += sc[k] * w; a1 += sc[1024 + k] * w; a2 += sc[2048 + k] * w; a3 += sc[3072 + k] * w; a4 += sc[4096 + k] * w; }
        red[(wave * 5 + 0) * 64 + lane] = a0; red[(wave * 5 + 1) * 64 + lane] = a1; red[(wave * 5 + 2) * 64 + lane] = a2; red[(wave * 5 + 3) * 64 + lane] = a3; red[(wave * 5 + 4) * 64 + lane] = a4;
        __syncthreads();
        if (tid < 320) { const int g = tid >> 6, ln = tid & 63; float s = P.b_ada[l * 9216 + cb * 64 + ln];
#pragma unroll
            for (int w = 0; w < 8; ++w) s += red[(w * 5 + g) * 64 + ln];
            mod[(size_t)(l * 5 + g) * 9216 + cb * 64 + ln] = s; }
        __syncthreads();
    }
}
__device__ __forceinline__ void tables_phase(const Params& P, unsigned char* ws, int gtid, int gthreads) {
    float2* r64 = (float2*)(ws + WS_ROPE64); float2* r8 = (float2*)(ws + WS_ROPE8); float* ssq = (float*)(ws + WS_SSQ);
    for (int i = gtid; i < 4096 * 64; i += gthreads) { const int t = i >> 6, f = i & 63; const float inv = powf(10000.0f, -(float)f / 64.0f); const float ang = (float)t * inv; r64[i] = make_float2(cosf(ang), sinf(ang)); }
    for (int i = gtid; i < 64 * 8; i += gthreads) { const int t = i >> 3, f = i & 7; const float inv = powf(10000.0f, -(float)f / 8.0f); const float ang = (float)t * inv; r8[i] = make_float2(cosf(ang), sinf(ang)); }
    for (int i = gtid; i < 4 * MT; i += gthreads) ssq[i] = 0.f;
}

__device__ __forceinline__ void row_phase(const Params& P, unsigned char* ws, int mode, const bf16* y, int l_u, int s_u, float coef, int l_h, int s_h, bool x_in, int gw, int ngw, int lane) {
    const float* mod = (const float*)(ws + WS_MOD); bf16* H = (bf16*)(ws + WS_H);
    const int rp = (MT + ngw - 1) / ngw, r0 = gw * rp, r1 = min(r0 + rp, MT);
    if (r0 >= r1) return;
    const int lo = lane * 4;
#define ROW_XS(m) (x_in ? ((m) < MC ? P.x_prompt + (size_t)(m) * DM : P.x_sample + (size_t)((m) - MC) * DM) : P.out + (size_t)(m) * DM)
    f32x4 xn[4]; u32x2 yn[4];
    { const float* xs = ROW_XS(r0);
#pragma unroll
      for (int j = 0; j < 4; ++j) { xn[j] = *(const f32x4*)(xs + lo + 256 * j); yn[j] = mode != 0 ? *(const u32x2*)(y + (size_t)r0 * DM + lo + 256 * j) : (u32x2){0u, 0u}; } }
    f32x4 gt[4], po[4], sh[4], sc[4], pr[4]; int gprev = -1;
#pragma unroll
    for (int j = 0; j < 4; ++j) { gt[j] = (f32x4){0.f, 0.f, 0.f, 0.f}; po[j] = gt[j]; sh[j] = gt[j]; sc[j] = gt[j]; pr[j] = gt[j]; }
    for (int m = r0; m < r1; ++m) {
        const int g = m >> 12;
        f32x4 xv[4], yv[4];
#pragma unroll
        for (int j = 0; j < 4; ++j) { xv[j] = xn[j]; yv[j] = (f32x4){bflo(yn[j].x), bfhi(yn[j].x), bflo(yn[j].y), bfhi(yn[j].y)}; }
        if (m + 1 < r1) { const float* xs = ROW_XS(m + 1);
#pragma unroll
            for (int j = 0; j < 4; ++j) { xn[j] = *(const f32x4*)(xs + lo + 256 * j); if (mode != 0) yn[j] = *(const u32x2*)(y + (size_t)(m + 1) * DM + lo + 256 * j); } }
        if (g != gprev) { gprev = g;
        if (mode != 0) { const float* gp = mod + (size_t)(l_u * 5 + g) * 9216 + (3 * s_u + 2) * DM; const float* pp = P.norm_post + (l_u * 3 + s_u) * DM;
#pragma unroll
            for (int j = 0; j < 4; ++j) { gt[j] = *(const f32x4*)(gp + lo + 256 * j); po[j] = *(const f32x4*)(pp + lo + 256 * j); } }
        if (mode != 2) { const float* shp = mod + (size_t)(l_h * 5 + g) * 9216 + (3 * s_h) * DM; const float* scp = shp + DM; const float* pp = P.norm_pre + (l_h * 3 + s_h) * DM;
#pragma unroll
            for (int j = 0; j < 4; ++j) { sh[j] = *(const f32x4*)(shp + lo + 256 * j); sc[j] = *(const f32x4*)(scp + lo + 256 * j); pr[j] = *(const f32x4*)(pp + lo + 256 * j); } }
        }
        if (mode != 0) {
            float ss = 0.f;
#pragma unroll
            for (int j = 0; j < 4; ++j) ss += (yv[j][0] * yv[j][0] + yv[j][1] * yv[j][1]) + (yv[j][2] * yv[j][2] + yv[j][3] * yv[j][3]);
            const float rs = rsqrtf(wave_sum(ss) * (1.0f / DM) + EPS) * coef;
#pragma unroll
            for (int j = 0; j < 4; ++j) { xv[j] += gt[j] * (yv[j] * rs * po[j]); *(f32x4*)(P.out + (size_t)m * DM + lo + 256 * j) = xv[j]; }
        }
        if (mode != 2) {
            float ss = 0.f;
#pragma unroll
            for (int j = 0; j < 4; ++j) ss += (xv[j][0] * xv[j][0] + xv[j][1] * xv[j][1]) + (xv[j][2] * xv[j][2] + xv[j][3] * xv[j][3]);
            const float rs = rsqrtf(wave_sum(ss) * (1.0f / DM) + EPS);
#pragma unroll
            for (int j = 0; j < 4; ++j) { const f32x4 h = (xv[j] * rs * pr[j]) * (1.0f + sc[j]) + sh[j];
                u32x2 o; o.x = pk(h[0], h[1]); o.y = pk(h[2], h[3]);
                *(u32x2*)(H + (size_t)m * DM + lo + 256 * j) = o; }
        }
    }
#undef ROW_XS
}

__device__ __forceinline__ void cache_kr_job(const Params& P, unsigned char* ws, int l, int gtid, int gthreads) {
    bf16* Klat = (bf16*)(ws + WS_K) + K_CTX_ROWS * 96;
    for (int it = gtid; it < 2048 * 8 * 4; it += gthreads) {
        const int c8 = (it & 3) * 8, h = (it >> 2) & 7, j = it >> 5, b = j >> 9, key = j & 511;
        const float* s = P.cache_kr + ((size_t)(b * 2 + l) * 512 + key) * 32;
        float v[8];
#pragma unroll
        for (int i = 0; i < 8; ++i) v[i] = s[kr_logical(c8 + i)];
        u32x4 o; o.x = pk(v[0], v[1]); o.y = pk(v[2], v[3]); o.z = pk(v[4], v[5]); o.w = pk(v[6], v[7]);
        *(u32x4*)(Klat + ((size_t)(b * 8 + h) * 4608 + 4096 + key) * 96 + 64 + c8) = o;
    }
}
__device__ __forceinline__ void ckv_out_job(const Params& P, unsigned char* ws, int l, int gtid, int gthreads) {
    const float* kvf = (const float*)(ws + WS_KVF32); const float* ssq = (const float*)(ws + WS_SSQ) + (size_t)(l * 2 + 1) * MT;
    for (int it = gtid; it < MC * 32; it += gthreads) {
        const int row = it >> 5, c4 = (it & 31) * 4;
        const float rs = rsqrtf(ssq[row] * (1.0f / 128.0f) + EPS);
        const f32x4 v = *(const f32x4*)(kvf + (size_t)row * 128 + c4), g = *(const f32x4*)(P.kv_norm + l * 128 + c4);
        *(f32x4*)(P.out + OUT_CKV + ((size_t)((row >> 8) * 2 + l) * 256 + (row & 255)) * 128 + c4) = v * rs * g;
    }
}
__device__ __forceinline__ void pool_job(const Params& P, unsigned char* ws, int gtid, int gthreads) {
    const bf16* pu = (const bf16*)(ws + WS_PU); bf16* yp = (bf16*)(ws + WS_YPOOL);
    for (int it = gtid; it < MT * 64; it += gthreads) {
        const int row = it >> 6, c8 = (it & 63) * 8, hw = 1 << (c8 >> 7);
        int t, n, r0; if (row < MC) { t = row & 255; n = 256; r0 = row - t; } else { t = (row - MC) & 4095; n = 4096; r0 = row - t; }
        const int lo = max(t - hw, 0), hi = min(t + hw, n);
        float s[8] = {0.f, 0.f, 0.f, 0.f, 0.f, 0.f, 0.f, 0.f};
        u32x4 wv[16];
#pragma unroll
        for (int k = 0; k < 16; ++k) { const int q = lo + k; wv[k] = (u32x4){0u, 0u, 0u, 0u}; if (q < hi) wv[k] = *(const u32x4*)(pu + (size_t)(r0 + q) * 512 + c8); }
#pragma unroll
        for (int k = 0; k < 16; ++k) { const u32x4 w = wv[k];
            s[0] += bflo(w.x); s[1] += bfhi(w.x); s[2] += bflo(w.y); s[3] += bfhi(w.y); s[4] += bflo(w.z); s[5] += bfhi(w.z); s[6] += bflo(w.w); s[7] += bfhi(w.w); }
        const float inv = 1.0f / (float)(hi - lo);
        const u32x4 w = *(const u32x4*)(pu + (size_t)row * 512 + c8);
        u32x4 o; o.x = pk(s[0] * inv - bflo(w.x), s[1] * inv - bfhi(w.x)); o.y = pk(s[2] * inv - bflo(w.y), s[3] * inv - bfhi(w.y));
        o.z = pk(s[4] * inv - bflo(w.z), s[5] * inv - bfhi(w.z)); o.w = pk(s[6] * inv - bflo(w.w), s[7] * inv - bfhi(w.w));
        *(u32x4*)(yp + (size_t)row * 512 + c8) = o;
    }
}

#define MFMA16(a, b, c) __builtin_amdgcn_mfma_f32_16x16x32_bf16((a), (b), (c), 0, 0, 0)
constexpr int AT_KS = 208, AT_VS = 144, AT_VOFF = 64 * 208, AT_BUF = 64 * 208 + 64 * 144;
__device__ __forceinline__ bf16x8 mk8(u32x2 lo, u32x2 hi) { u32x4 w = {lo.x, lo.y, hi.x, hi.y}; return __builtin_bit_cast(bf16x8, w); }

__device__ __forceinline__ void attn_phase(const Params& P, unsigned char* ws, LAS unsigned char* lds, int tid, int wave, int lane) {
    const bf16* Q = (const bf16*)(ws + WS_Q); const bf16* Kctx = (const bf16*)(ws + WS_K); const bf16* Klat = Kctx + K_CTX_ROWS * 96;
    const bf16* Vctx = (const bf16*)(ws + WS_VT); const bf16* Vlat = Vctx + V_CTX_ROWS * 256; bf16* oa = (bf16*)(ws + WS_QKC);
    const int fr = lane & 15, fq = lane >> 4;
    const int q1 = tid + 512, k0r = tid / 12, k0c = tid - k0r * 12, k1r = q1 / 12, k1c = q1 - k1r * 12, ve = tid >> 3, vc = tid & 7;
    for (int ui0 = blockIdx.x; ui0 < 640; ui0 += gridDim.x) {
        int ui = ui0;
        if (ui0 < 512 && gridDim.x == 256) { const int k = ui0 >> 8, c = ui0 & 255, x = c & 7, j = c >> 3; ui = ((k * 16 + x * 2 + (j >> 4)) << 4) + (j & 15); }
        int h, nk, qrow0; const bf16 *Kb, *Vb;
        if (ui < 512) { const int b = ui >> 7, qb = ui & 15; h = (ui >> 4) & 7; nk = 4608; qrow0 = MC + b * 4096 + qb * 256; Kb = Klat + (size_t)(b * 8 + h) * 4608 * 96; Vb = Vlat + (size_t)(b * 8 + h) * 64 * 4608; }
        else { const int v = ui - 512, b = v >> 3; h = v & 7; nk = 256; qrow0 = b * 256; Kb = Kctx + (size_t)(b * 8 + h) * 256 * 96; Vb = Vctx + (size_t)(b * 8 + h) * 64 * 256; }
        const int nt = nk >> 6;
        bf16x8 qf[2][3];
#pragma unroll
        for (int ib = 0; ib < 2; ++ib)
#pragma unroll
            for (int ks = 0; ks < 3; ++ks) qf[ib][ks] = *(const bf16x8*)(Q + (size_t)(qrow0 + wave * 32 + ib * 16 + fr) * 768 + h * 96 + ks * 32 + fq * 8);
        f32x4 o[4][2];
#pragma unroll
        for (int eb = 0; eb < 4; ++eb) { o[eb][0] = (f32x4){0.f, 0.f, 0.f, 0.f}; o[eb][1] = (f32x4){0.f, 0.f, 0.f, 0.f}; }
        float mrun[2] = {-1e30f, -1e30f}, lrun[2] = {0.f, 0.f};
        u32x4 kr0, kr1 = {0u, 0u, 0u, 0u}, vr;
#define AT_LOAD(t) do { const bf16* kt_ = Kb + (size_t)(t) * 64 * 96; kr0 = *(const u32x4*)(kt_ + tid * 8); if (tid < 256) kr1 = *(const u32x4*)(kt_ + q1 * 8); \
        vr = *(const u32x4*)(Vb + (size_t)ve * nk + (t) * 64 + vc * 8); } while (0)
#define AT_STORE(buf) do { LAS unsigned char* B_ = lds + (buf) * AT_BUF; *(LAS u32x4*)(B_ + k0r * AT_KS + k0c * 16) = kr0; if (tid < 256) *(LAS u32x4*)(B_ + k1r * AT_KS + k1c * 16) = kr1; \
        *(LAS u32x4*)(B_ + AT_VOFF + ve * AT_VS + vc * 16) = vr; } while (0)
        AT_LOAD(0); AT_STORE(0); __syncthreads();
        for (int t = 0; t < nt; ++t) {
            if (t + 1 < nt) AT_LOAD(t + 1);
            const LAS unsigned char* B = lds + (t & 1) * AT_BUF;
            f32x4 s[4][2];
            __builtin_amdgcn_s_setprio(1);
#pragma unroll
            for (int jb = 0; jb < 4; ++jb) {
                bf16x8 kf[3];
#pragma unroll
                for (int ks = 0; ks < 3; ++ks) kf[ks] = *(const LAS bf16x8*)(B + (jb * 16 + fr) * AT_KS + ks * 64 + fq * 16);
#pragma unroll
                for (int ib = 0; ib < 2; ++ib) { f32x4 a = {0.f, 0.f, 0.f, 0.f};
#pragma unroll
                    for (int ks = 0; ks < 3; ++ks) a = MFMA16(kf[ks], qf[ib][ks], a);
                    s[jb][ib] = a; }
            }
            __builtin_amdgcn_s_setprio(0);
            bf16x8 pb[2][2];
#pragma unroll
            for (int ib = 0; ib < 2; ++ib) {
                float mx = -1e30f;
#pragma unroll
                for (int jb = 0; jb < 4; ++jb) mx = fmaxf(mx, fmaxf(fmaxf(s[jb][ib][0], s[jb][ib][1]), fmaxf(s[jb][ib][2], s[jb][ib][3])));
                mx = fmaxf(mx, __shfl_xor(mx, 16)); mx = fmaxf(mx, __shfl_xor(mx, 32));
                const float mnew = fmaxf(mrun[ib], mx), alpha = fast_exp2(mrun[ib] - mnew); mrun[ib] = mnew;
                float ls = 0.f;
#pragma unroll
                for (int jb = 0; jb < 4; ++jb)
#pragma unroll
                    for (int r = 0; r < 4; ++r) { const float p = fast_exp2(s[jb][ib][r] - mnew); s[jb][ib][r] = p; ls += p; }
                lrun[ib] = lrun[ib] * alpha + ls;
#pragma unroll
                for (int eb = 0; eb < 4; ++eb) o[eb][ib] *= alpha;
                pb[0][ib] = __builtin_bit_cast(bf16x8, pack8(s[0][ib], s[1][ib])); pb[1][ib] = __builtin_bit_cast(bf16x8, pack8(s[2][ib], s[3][ib]));
            }
            __builtin_amdgcn_s_setprio(1);
#pragma unroll
            for (int eb = 0; eb < 4; ++eb)
#pragma unroll
                for (int kk = 0; kk < 2; ++kk) {
                    const LAS unsigned char* vp = B + AT_VOFF + (eb * 16 + fr) * AT_VS + fq * 8;
                    const bf16x8 vf = mk8(*(const LAS u32x2*)(vp + (2 * kk) * 32), *(const LAS u32x2*)(vp + (2 * kk + 1) * 32));
                    o[eb][0] = MFMA16(vf, pb[kk][0], o[eb][0]); o[eb][1] = MFMA16(vf, pb[kk][1], o[eb][1]);
                }
            __builtin_amdgcn_s_setprio(0);
            if (t + 1 < nt) AT_STORE((t + 1) & 1);
            __syncthreads();
        }
#pragma unroll
        for (int ib = 0; ib < 2; ++ib) {
            float l = lrun[ib]; l += __shfl_xor(l, 16); l += __shfl_xor(l, 32);
            const float inv = 1.0f / l;
            bf16* op = oa + (size_t)(qrow0 + wave * 32 + ib * 16 + fr) * 512 + h * 64 + fq * 4;
#pragma unroll
            for (int eb = 0; eb < 4; ++eb) { const f32x4 v = o[eb][ib] * inv; u32x2 w; w.x = pk(v[0], v[1]); w.y = pk(v[2], v[3]); *(u32x2*)(op + eb * 16) = w; }
        }
    }
#undef AT_LOAD
#undef AT_STORE
}

constexpr int RT_S = 272, RT_TILE = 128 * 272;
#define TSW_WBASE(cc, j) ((cc) * 8 * RT_S + (((((j) >> 3) ^ (cc)) & 15) << 4) + ((j) & 7) * 2)
#define TSW_RIMM(X, ks) ((X) * 16 * RT_S + ((((ks) << 2) ^ ((X) << 1)) & ~3) * 16)
__device__ __forceinline__ unsigned short f2bf1(float v) { return (unsigned short)(pk(v, 0.f) & 0xffffu); }
__device__ __forceinline__ void ret_decode(int ui, int& b, int& h, int& c, int& row0, bool& lat) {
    if (ui < 512) { lat = true; b = ui >> 7; h = (ui >> 5) & 3; c = ui & 31; row0 = MC + b * 4096 + c * 128; }
    else { const int v = ui - 512; lat = false; b = v >> 3; h = (v >> 1) & 3; c = v & 1; row0 = b * 256 + c * 128; }
}
__device__ __forceinline__ void ret_u_phase(const Params& P, unsigned char* ws, int l, LAS unsigned char* lds, int tid, int wave, int lane) {
    const bf16* rk = (const bf16*)(ws + WS_RK); const bf16* rv = (const bf16*)(ws + WS_RV);
    LAS unsigned char* Kt = lds; LAS unsigned char* Vf = lds + RT_TILE; LAS unsigned char* Vb = lds + 2 * RT_TILE;
    const int fr = lane & 15, fq = lane >> 4;
    const bool rebal = gridDim.x == 256;
    for (int ui0 = blockIdx.x; ui0 < (rebal ? 768 : 640); ui0 += gridDim.x) {
        int ui = ui0;
        if (rebal && ui0 >= 512) { if (ui0 < 640) continue; ui = ui0 - 128; }
        int b, h, c, row0; bool lat; ret_decode(ui, b, h, c, row0, lat);
        const float lgf2 = -expf(P.ret_decay[(l * 2 + 0) * 4 + h]) * LOG2E, lgb2 = -expf(P.ret_decay[(l * 2 + 1) * 4 + h]) * LOG2E;
#pragma unroll
        for (int i = 0; i < 4; ++i) {
            const int q = tid + 512 * i, j = q >> 4, cc = q & 15;
            const u32x4 kw = *(const u32x4*)(rk + (size_t)(row0 + j) * 512 + h * 128 + cc * 8), vw = *(const u32x4*)(rv + (size_t)(row0 + j) * 512 + h * 128 + cc * 8);
            const float sf = fast_exp2(lgf2 * (float)(127 - j)), sb = fast_exp2(lgb2 * (float)j);
            const unsigned kwa[4] = {kw.x, kw.y, kw.z, kw.w}, vwa[4] = {vw.x, vw.y, vw.z, vw.w};
            const int wb = TSW_WBASE(cc, j);
#pragma unroll
            for (int e2 = 0; e2 < 4; ++e2) {
                const int wo = wb + e2 * 2 * RT_S;
                *(LAS unsigned short*)(Kt + wo) = (unsigned short)(kwa[e2] & 0xffffu); *(LAS unsigned short*)(Kt + wo + RT_S) = (unsigned short)(kwa[e2] >> 16);
                const float v0 = bflo(vwa[e2]), v1 = bfhi(vwa[e2]);
                *(LAS unsigned short*)(Vf + wo) = f2bf1(v0 * sf); *(LAS unsigned short*)(Vf + wo + RT_S) = f2bf1(v1 * sf);
                *(LAS unsigned short*)(Vb + wo) = f2bf1(v0 * sb); *(LAS unsigned short*)(Vb + wo + RT_S) = f2bf1(v1 * sb);
            }
        }
        __syncthreads();
        const int rb[2] = {fr * RT_S + ((fq ^ (fr >> 3)) << 4), fr * RT_S + (((fq ^ (fr >> 3)) ^ 2) << 4)};
        f32x4 af[8], ab[8];
#pragma unroll
        for (int db = 0; db < 8; ++db) { af[db] = (f32x4){0.f, 0.f, 0.f, 0.f}; ab[db] = (f32x4){0.f, 0.f, 0.f, 0.f}; }
#pragma unroll
        for (int ks = 0; ks < 4; ++ks) {
            const int vo = (wave * 16 + fr) * RT_S + (((((ks << 2) | fq) ^ ((wave << 1) | (fr >> 3))) & 15) << 4);
            const bf16x8 vf = *(const LAS bf16x8*)(Vf + vo), vb = *(const LAS bf16x8*)(Vb + vo);
#pragma unroll
            for (int db = 0; db < 8; ++db) { const bf16x8 kf = *(const LAS bf16x8*)(Kt + rb[db & 1] + TSW_RIMM(db, ks));
                af[db] = MFMA16(vf, kf, af[db]); ab[db] = MFMA16(vb, kf, ab[db]); }
        }
        const int bh = b * 4 + h;
        __syncthreads();
        if (lat) {
            LAS unsigned char* Tf = lds; LAS unsigned char* Tb = lds + RT_TILE;
#pragma unroll
            for (int db = 0; db < 8; ++db)
#pragma unroll
                for (int r = 0; r < 4; ++r) { const int off = (wave * 16 + fq * 4 + r) * RT_S + (db * 16 + fr) * 2;
                    *(LAS unsigned short*)(Tf + off) = f2bf1(af[db][r]); *(LAS unsigned short*)(Tb + off) = f2bf1(ab[db][r]); }
            __syncthreads();
            bf16* Uf = (bf16*)(ws + WS_ULAT) + ((size_t)((bh * 2 + 0) * 32 + c)) * 16384; bf16* Ub = (bf16*)(ws + WS_ULAT) + ((size_t)((bh * 2 + 1) * 32 + c)) * 16384;
#pragma unroll
            for (int i = 0; i < 4; ++i) { const int q = tid + 512 * i, row = q >> 4, cc = q & 15;
                *(u32x4*)(Uf + row * 128 + cc * 8) = *(const LAS u32x4*)(Tf + row * RT_S + cc * 16); *(u32x4*)(Ub + row * 128 + cc * 8) = *(const LAS u32x4*)(Tb + row * RT_S + cc * 16); }
        } else {
            LAS unsigned char* Tf = lds; LAS unsigned char* Tb = lds + 128 * 528;
#pragma unroll
            for (int db = 0; db < 8; ++db)
#pragma unroll
                for (int r = 0; r < 4; ++r) { const int off = (wave * 16 + fq * 4 + r) * 528 + (db * 16 + fr) * 4;
                    *(LAS float*)(Tf + off) = af[db][r]; *(LAS float*)(Tb + off) = ab[db][r]; }
            __syncthreads();
            float* Uf = (float*)(ws + WS_UCTX) + ((size_t)((bh * 2 + 0) * 2 + c)) * 16384; float* Ub = (float*)(ws + WS_UCTX) + ((size_t)((bh * 2 + 1) * 2 + c)) * 16384;
#pragma unroll
            for (int i = 0; i < 8; ++i) { const int q = tid + 512 * i, row = q >> 5, cc = q & 31;
                *(f32x4*)(Uf + row * 128 + cc * 4) = *(const LAS f32x4*)(Tf + row * 528 + cc * 16); *(f32x4*)(Ub + row * 128 + cc * 4) = *(const LAS f32x4*)(Tb + row * 528 + cc * 16); }
        }
        __syncthreads();
    }
}
__device__ __forceinline__ void ret_scan_phase(const Params& P, unsigned char* ws, int l, int gtid, int gthreads) {
    for (int it = gtid; it < 32 * 16384; it += gthreads) {
        const int off = it & 16383, bhd = it >> 14, dir = bhd & 1, bh = bhd >> 1, b = bh >> 2, h = bh & 3, e = off >> 7, dp = off & 127, dl = (dp >> 1) + ((dp & 1) << 6);
        float s = P.state_ret[((((size_t)(b * 2 + l) * 2 + dir) * 4 + h) * 128 + dl) * 128 + e];
        const float dec = fast_exp2(-expf(P.ret_decay[(l * 2 + dir) * 4 + h]) * LOG2E * 128.0f);
        bf16* U = (bf16*)(ws + WS_ULAT) + (size_t)bhd * 32 * 16384 + off;
        const int c0 = dir ? 31 : 0, cs = dir ? -1 : 1;
        float u[32];
#pragma unroll
        for (int c = 0; c < 32; ++c) u[c] = bf2f(U[(size_t)(c0 + cs * c) * 16384]);
#pragma unroll
        for (int c = 0; c < 32; ++c) { U[(size_t)(c0 + cs * c) * 16384] = f2bf1(s); s = dec * s + u[c]; }
    }
#pragma unroll 4
    for (int it = gtid; it < 128 * 16384; it += gthreads) {
        const int off = it & 16383, bhd = it >> 14, dir = bhd & 1, bh = bhd >> 1, b = bh >> 2, h = bh & 3, e = off >> 7, dp = off & 127, dl = (dp >> 1) + ((dp & 1) << 6);
        const float dec = fast_exp2(-expf(P.ret_decay[(l * 2 + dir) * 4 + h]) * LOG2E * 128.0f);
        const float* U = (const float*)(ws + WS_UCTX) + (size_t)bhd * 2 * 16384 + off; bf16* S = (bf16*)(ws + WS_SCTX) + (size_t)bhd * 2 * 16384 + off;
        const float u0 = U[0], u1 = U[16384]; float s;
        if (dir == 0) { S[0] = 0; S[16384] = f2bf1(u0); s = dec * u0 + u1; }
        else { S[16384] = 0; S[0] = f2bf1(u1); s = dec * u1 + u0; }
        P.out[OUT_ST + ((((size_t)(b * 2 + l) * 2 + dir) * 4 + h) * 128 + dl) * 128 + e] = s;
    }
}
__device__ __forceinline__ bf16x8 scale8(bf16x8 q, float s) {
    const u32x4 w = __builtin_bit_cast(u32x4, q); u32x4 o;
    o.x = pk(bflo(w.x) * s, bfhi(w.x) * s); o.y = pk(bflo(w.y) * s, bfhi(w.y) * s); o.z = pk(bflo(w.z) * s, bfhi(w.z) * s); o.w = pk(bflo(w.w) * s, bfhi(w.w) * s);
    return __builtin_bit_cast(bf16x8, o);
}
__device__ __forceinline__ void ret_out_phase(const Params& P, unsigned char* ws, int l, LAS unsigned char* lds, int tid, int wave, int lane, bf16* dst) {
    const bf16* rq = (const bf16*)(ws + WS_RQ); const bf16* rk = (const bf16*)(ws + WS_RK); const bf16* rv = (const bf16*)(ws + WS_RV); bf16* rgs = (bf16*)(ws + WS_RGS);
    LAS unsigned char* Ks = lds; LAS unsigned char* Vt = lds + RT_TILE;
    const int fr = lane & 15, fq = lane >> 4, iloc = wave * 16 + fr;
    for (int ui = blockIdx.x; ui < 640; ui += gridDim.x) {
        int b, h, c, row0; bool lat; ret_decode(ui, b, h, c, row0, lat);
        const float lgf2 = -expf(P.ret_decay[(l * 2 + 0) * 4 + h]) * LOG2E, lgb2 = -expf(P.ret_decay[(l * 2 + 1) * 4 + h]) * LOG2E;
        const int bh = b * 4 + h;
        const bf16* Sf = lat ? (const bf16*)(ws + WS_ULAT) + ((size_t)((bh * 2 + 0) * 32 + c)) * 16384 : (const bf16*)(ws + WS_SCTX) + ((size_t)((bh * 2 + 0) * 2 + c)) * 16384;
        const bf16* Sb = lat ? (const bf16*)(ws + WS_ULAT) + ((size_t)((bh * 2 + 1) * 32 + c)) * 16384 : (const bf16*)(ws + WS_SCTX) + ((size_t)((bh * 2 + 1) * 2 + c)) * 16384;
#pragma unroll
        for (int i = 0; i < 4; ++i) {
            const int q = tid + 512 * i, j = q >> 4, cc = q & 15;
            const u32x4 kw = *(const u32x4*)(rk + (size_t)(row0 + j) * 512 + h * 128 + cc * 8), vw = *(const u32x4*)(rv + (size_t)(row0 + j) * 512 + h * 128 + cc * 8);
            *(LAS u32x4*)(Ks + j * RT_S + cc * 16) = kw;
            *(LAS u32x4*)(lds + 2 * RT_TILE + j * RT_S + cc * 16) = *(const u32x4*)(Sf + (size_t)j * 128 + cc * 8);
            *(LAS u32x4*)(lds + 3 * RT_TILE + j * RT_S + cc * 16) = *(const u32x4*)(Sb + (size_t)j * 128 + cc * 8);
            const unsigned vwa[4] = {vw.x, vw.y, vw.z, vw.w};
#pragma unroll
            for (int e2 = 0; e2 < 4; ++e2) { const int wo = TSW_WBASE(cc, j) + e2 * 2 * RT_S;
                *(LAS unsigned short*)(Vt + wo) = (unsigned short)(vwa[e2] & 0xffffu); *(LAS unsigned short*)(Vt + wo + RT_S) = (unsigned short)(vwa[e2] >> 16); }
        }
        bf16x8 qf[4];
#pragma unroll
        for (int ks = 0; ks < 4; ++ks) qf[ks] = *(const bf16x8*)(rq + (size_t)(row0 + iloc) * 512 + h * 128 + ks * 32 + fq * 8);
        __syncthreads();
        f32x4 s[8];
#pragma unroll
        for (int jb = 0; jb < 8; ++jb) { f32x4 a = {0.f, 0.f, 0.f, 0.f};
#pragma unroll
            for (int ks = 0; ks < 4; ++ks) { const bf16x8 kf = *(const LAS bf16x8*)(Ks + (jb * 16 + fr) * RT_S + (ks * 32 + fq * 8) * 2); a = MFMA16(kf, qf[ks], a); }
#pragma unroll
            for (int r = 0; r < 4; ++r) { const int diff = iloc - (jb * 16 + fq * 4 + r);
                const float w = (diff >= 0 ? fast_exp2(lgf2 * (float)diff) : 0.f) + (diff <= 0 ? fast_exp2(-lgb2 * (float)diff) : 0.f); a[r] *= w; }
            s[jb] = a; }
        const int vrb = fr * RT_S + (((fq >> 1) ^ (fr >> 3)) << 4) + (fq & 1) * 8;
        f32x4 o[8];
#pragma unroll
        for (int eb = 0; eb < 8; ++eb) o[eb] = (f32x4){0.f, 0.f, 0.f, 0.f};
#pragma unroll
        for (int kk = 0; kk < 4; ++kk) {
            const bf16x8 pb = __builtin_bit_cast(bf16x8, pack8(s[2 * kk], s[2 * kk + 1]));
#pragma unroll
            for (int eb = 0; eb < 8; ++eb) { const LAS unsigned char* vp = Vt + vrb + eb * 16 * RT_S;
                const bf16x8 vf = mk8(*(const LAS u32x2*)(vp + (((4 * kk) ^ (eb << 1)) & 15) * 16), *(const LAS u32x2*)(vp + (((4 * kk + 2) ^ (eb << 1)) & 15) * 16));
                o[eb] = MFMA16(vf, pb, o[eb]); }
        }
        const float qdf = fast_exp2(lgf2 * (float)(iloc + 1)), qdb = fast_exp2(lgb2 * (float)(128 - iloc));
#pragma unroll
        for (int ks = 0; ks < 4; ++ks) {
            const bf16x8 qsf = scale8(qf[ks], qdf), qsb = scale8(qf[ks], qdb);
#pragma unroll
            for (int eb = 0; eb < 8; ++eb) {
                const bf16x8 a_f = *(const LAS bf16x8*)(lds + 2 * RT_TILE + (eb * 16 + fr) * RT_S + (ks * 32 + fq * 8) * 2), a_b = *(const LAS bf16x8*)(lds + 3 * RT_TILE + (eb * 16 + fr) * RT_S + (ks * 32 + fq * 8) * 2);
                o[eb] = MFMA16(a_f, qsf, o[eb]); o[eb] = MFMA16(a_b, qsb, o[eb]); }
        }
        float ss = 0.f;
#pragma unroll
        for (int eb = 0; eb < 8; ++eb) ss += (o[eb][0] * o[eb][0] + o[eb][1] * o[eb][1]) + (o[eb][2] * o[eb][2] + o[eb][3] * o[eb][3]);
        ss += __shfl_xor(ss, 16); ss += __shfl_xor(ss, 32);
        const float rs = rsqrtf(ss * (1.0f / 128.0f) + EPS);
        bf16* gp = rgs + (size_t)(row0 + iloc) * 512 + h * 128 + fq * 4;
#pragma unroll
        for (int eb = 0; eb < 8; ++eb) { const u32x2 g = *(const u32x2*)(gp + eb * 16);
            u32x2 w; w.x = pk(o[eb][0] * rs * bflo(g.x), o[eb][1] * rs * bfhi(g.x)); w.y = pk(o[eb][2] * rs * bflo(g.y), o[eb][3] * rs * bfhi(g.y));
            *(u32x2*)(dst + (gp - rgs) + eb * 16) = w; }
        __syncthreads();
    }
}

constexpr size_t WS_BAR = 896 * 1024;
#define XB_TMO      128
#define XB_XCNT(j)  (256  + 64 * (j))
#define XB_XSUB(j)  (1280 + 64 * (j))
#define XB_XGEN(j)  (2304 + 64 * (j))
#define XB_TOP      3328
#define XB_TOPGEN   3392
#define XCD_BAR_WORDS 3456
#define XB_SPIN_CAP (1u << 18)

__device__ __forceinline__ unsigned xb_ld(unsigned* p)              { return __hip_atomic_load(p, __ATOMIC_RELAXED, __HIP_MEMORY_SCOPE_AGENT); }
__device__ __forceinline__ unsigned xb_add(unsigned* p, unsigned v) { return __hip_atomic_fetch_add(p, v, __ATOMIC_RELAXED, __HIP_MEMORY_SCOPE_AGENT); }
__device__ __forceinline__ unsigned xb_xcc_id() { return (unsigned)__builtin_amdgcn_s_getreg((3 << 11) | 20) & 0xFu; }
#define XB_SPIN(cond, bar) do { unsigned _sp = 0; while (cond) { __builtin_amdgcn_s_sleep(1); \
    if ((++_sp & 255u) == 0u) { if (xb_ld(&(bar)[XB_TMO])) break; if (_sp > XB_SPIN_CAP) { atomicAdd(&(bar)[XB_TMO], 1u); break; } } } } while (0)

struct XcdBarrier {
    unsigned* bar; unsigned x;
    volatile LAS unsigned* st;
};

__device__ __forceinline__ XcdBarrier xcd_barrier_post(unsigned* bar, volatile LAS unsigned* st) {
    XcdBarrier b; b.bar = bar; b.x = xb_xcc_id(); b.st = st;
    if (threadIdx.x == 0) (void)xb_add(&bar[XB_XCNT(b.x)], 1u);
    return b;
}
__device__ __forceinline__ void xcd_barrier_complete(unsigned* bar, unsigned x, unsigned& nloc, unsigned& nx) {
    const unsigned G = gridDim.x * gridDim.y * gridDim.z;
    unsigned sum, cnt, mine, sp = 0u;
    for (;;) {
        sum = 0u; cnt = 0u; mine = 0u;
#pragma unroll
        for (unsigned j = 0; j < 16; ++j) { const unsigned c = xb_ld(&bar[XB_XCNT(j)]); sum += c; cnt += (c > 0u) ? 1u : 0u; mine = (j == x) ? c : mine; }
        if (sum == G) break;
        __builtin_amdgcn_s_sleep(1);
        if ((++sp & 255u) == 0u) { if (xb_ld(&bar[XB_TMO])) break; if (sp > XB_SPIN_CAP) { atomicAdd(&bar[XB_TMO], 1u); break; } }
    }
    nloc = mine > 0u ? mine : 1u; nx = cnt > 0u ? cnt : 1u;
}

__device__ __forceinline__ void xcd_barrier(const XcdBarrier& b) {
    asm volatile("s_waitcnt vmcnt(0)" ::: "memory");
    __syncthreads();
    if (threadIdx.x == 0) {
        unsigned* bar = b.bar;
        __builtin_amdgcn_s_waitcnt(0);
        unsigned nloc = b.st[0], nx = b.st[1];
        if (nloc == 0u) { xcd_barrier_complete(bar, b.x, nloc, nx); b.st[0] = nloc; b.st[1] = nx; }
        const unsigned old = xb_add(&bar[XB_XSUB(b.x)], 1u);
        const unsigned gen = old / nloc;
        if (old + 1u == (gen + 1u) * nloc) {
            __builtin_amdgcn_fence(__ATOMIC_RELEASE, "agent");
            asm volatile("s_waitcnt vmcnt(0)" ::: "memory");
            const unsigned og = xb_add(&bar[XB_TOP], 1u);
            const unsigned tg = og / nx;
            if (og + 1u == (tg + 1u) * nx) xb_add(&bar[XB_TOPGEN], 1u);
            else XB_SPIN(xb_ld(&bar[XB_TOPGEN]) == tg, bar);
            __builtin_amdgcn_fence(__ATOMIC_ACQUIRE, "agent");
            xb_add(&bar[XB_XGEN(b.x)], 1u);
            asm volatile("s_waitcnt vmcnt(0)" ::: "memory");
        } else {
            XB_SPIN(xb_ld(&bar[XB_XGEN(b.x)]) == gen, bar);
            __builtin_amdgcn_fence(__ATOMIC_ACQUIRE, "agent");
            asm volatile("s_waitcnt vmcnt(0)" ::: "memory");
        }
    }
    __syncthreads();
}

constexpr int LDS_BYTES = 147456;
#ifndef REP_ATTN
#define REP_ATTN 1
#endif
#ifndef REP_FFN
#define REP_FFN 1
#endif
#ifndef REP_CONV
#define REP_CONV 1
#endif
#ifndef REP_MERGE
#define REP_MERGE 1
#endif
#ifndef REP_M2
#define REP_M2 1
#endif
#ifndef REP_WOUT
#define REP_WOUT 1
#endif
#ifndef REP_PRO
#define REP_PRO 1
#endif
#ifndef REP_POOL
#define REP_POOL 1
#endif
#ifndef REP_RETU
#define REP_RETU 1
#endif
#ifndef REP_QKV
#define REP_QKV 1
#endif
#ifndef REP_RETO
#define REP_RETO 1
#endif
#ifndef REP_WINB
#define REP_WINB 1
#endif
#ifndef REP_SYNC
#define REP_SYNC 0
#endif
template <class Epi> __device__ __forceinline__ void run_gemm(LAS unsigned char* lds, const bf16* A, const bf16* Bt, int M, int N, int K, int rot, const Epi& E) {
    pg8::Gemm g{A, Bt, M, N, K}; pg8::StaticOrder S; const int G = (int)gridDim.x; S.init(M, N, G, (int)((blockIdx.x + G - rot) % G));
    pg8::gemm_phase<Epi, pg8::StaticOrder, true, true>(lds, g, S, E);
}
#define PHASE_VIEW() \
    int tid = threadIdx.x; asm volatile("" : "+v"(tid)); unsigned char* ws = P.ws; asm volatile("" : "+s"(ws)); \
    const int lane = tid & 63, wave = __builtin_amdgcn_readfirstlane(tid >> 6); \
    const int G = gridDim.x, gw = blockIdx.x * 8 + wave, ngw = G * 8, gtid = blockIdx.x * 512 + tid, gthreads = G * 512; \
    LAS float* scr = (LAS float*)(lds + wave * 8448); unsigned char* wa = ws + WS_W; \
    (void)lane; (void)G; (void)gw; (void)ngw; (void)gtid; (void)gthreads; (void)scr; (void)wa;
#define GSYNC() do { XcdBarrier xb_; xb_.bar = (unsigned*)(P.ws + WS_BAR); xb_.x = (unsigned)__builtin_amdgcn_readfirstlane((int)xbar.x); xb_.st = (volatile LAS unsigned*)((LAS unsigned char*)lds + LDS_BYTES - 64); xcd_barrier(xb_); } while (0)

#define CONV_VIEW() const bool csk = (int)gridDim.x > 128; const int cgw = csk ? ((int)blockIdx.x - 64) * 8 + wave : gw, cngw = csk ? ((int)gridDim.x - 64) * 8 : ngw; const bool cdo = !csk || (int)blockIdx.x >= 64
__device__ __forceinline__ void ffn_phases(const Params& P, const XcdBarrier& xbar, LAS unsigned char* lds, int job, int l) {
    for (int rep = 0; rep < REP_FFN; ++rep) { PHASE_VIEW(); run_gemm(lds, (const bf16*)(ws + WS_H), (const bf16*)(wa + WA_GU), MT, 2 * DFF, DM, 0, EpiGU{(bf16*)(ws + WS_ACT)}); }
    GSYNC();
    for (int rep = 0; rep < REP_FFN; ++rep) { PHASE_VIEW(); run_gemm(lds, (const bf16*)(ws + WS_ACT), (const bf16*)(wa + WA_D), MT, DM, DFF, 0, EpiBf16{(bf16*)(ws + WS_YF), DM}); }
    { PHASE_VIEW(); CONV_VIEW();
      if (cdo) { if (job == 1) conv_win(P, ws, l, scr, cgw, cngw, lane);
                 else if (job == 2) conv_job(P.ffn1_gu + (size_t)DM * 2 * DFF, DM, 2 * DFF, (bf16*)(ws + WS_W + WA_GU), DM, 2 * DFF, 1, nullptr, scr, cgw, cngw, lane); } }
    GSYNC();
    for (int rep = 0; rep < REP_SYNC; ++rep) GSYNC();
}

__global__ void __launch_bounds__(512, 2) fwd_kernel(Params P) {
    extern __shared__ __attribute__((aligned(16))) unsigned char lds_raw[];
    cg::grid_group grid = cg::this_grid();
    LAS unsigned char* lds = (LAS unsigned char*)lds_raw;
    volatile LAS unsigned* xst = (volatile LAS unsigned*)(lds + LDS_BYTES - 64);
    if (threadIdx.x < 2) xst[threadIdx.x] = 0u;
    __syncthreads();
    const XcdBarrier xbar = xcd_barrier_post((unsigned*)(P.ws + WS_BAR), xst);

    { PHASE_VIEW();
      for (int rep = 0; rep < REP_PRO; ++rep) { conv_ffn(P.ffn1_gu, P.ffn1_d, ws, scr, gw, ngw, lane);
      mod_phase(P, ws, (LAS float*)(lds + 8 * 8448), tid, wave, lane); }
      tables_phase(P, ws, gtid, gthreads); }
    if (P.ws == nullptr) grid.sync();
    GSYNC();
    { PHASE_VIEW(); row_phase(P, ws, 0, nullptr, 0, 0, 0.f, 0, 0, true, gw, ngw, lane); }
    GSYNC();
#pragma unroll 1
    for (int l = 0; l < 2; ++l) {
        ffn_phases(P, xbar, lds, 1, l);
        { PHASE_VIEW();
          row_phase(P, ws, 1, (const bf16*)(ws + WS_YF), l, 0, 0.5f, l, 1, l == 0, gw, ngw, lane);
          for (int rep = 0; rep < REP_CONV; ++rep) conv_mixer(P, ws, l, scr, gw, ngw, lane, gtid, gthreads); }
        GSYNC();
        { PHASE_VIEW();
          run_gemm(lds, (const bf16*)(ws + WS_H), (const bf16*)(wa + WA_INB), MT, 3072, DM, 0, EpiWinB{ws, P.out, l});
          cache_kr_job(P, ws, l, gtid, gthreads); }
        GSYNC();
        { PHASE_VIEW();
          const float* ssq = (const float*)(ws + WS_SSQ) + (size_t)l * 2 * MT;
          bf16* QKC = (bf16*)(ws + WS_QKC); bf16* Kctx = (bf16*)(ws + WS_K); bf16* Klat = Kctx + K_CTX_ROWS * 96; bf16* Vctx = (bf16*)(ws + WS_VT); bf16* Vlat = Vctx + V_CTX_ROWS * 256;
          const bf16* kvc = QKC + (size_t)MT * 256; const bf16* ca = (const bf16*)(ws + WS_CACHEA);
          for (int rep = 0; rep < REP_QKV; ++rep) {
          run_gemm(lds, QKC, (const bf16*)(wa + WA_UQ), MT, 768, 256, 0, EpiQ{(bf16*)(ws + WS_Q), ssq, (const float2*)(ws + WS_ROPE8)});
          run_gemm(lds, kvc, (const bf16*)(wa + WA_KF), MT, 512, 256, 240 % G, EpiK{Kctx, Klat, ssq + MT, 0});
          run_gemm(lds, ca, (const bf16*)(wa + WA_KP), 2048, 512, 256, 144 % G, EpiK{Kctx, Klat, ssq + MT, 1});
          run_gemm(lds, (const bf16*)(wa + WA_VF), kvc, 512, MT, 256, 160 % G, EpiVt{Vctx, Vlat, ssq + MT, 0});
          run_gemm(lds, (const bf16*)(wa + WA_VP), ca, 512, 2048, 256, 64 % G, EpiVt{Vctx, Vlat, ssq + MT, 1}); } }
        { PHASE_VIEW();
          for (int rep = 0; rep < REP_POOL; ++rep) pool_job(P, ws, gtid, gthreads);
          for (int rep = 0; rep < REP_RETU; ++rep) ret_u_phase(P, ws, l, lds, tid, wave, lane);
          ckv_out_job(P, ws, l, gtid, gthreads); }
        GSYNC();
        { PHASE_VIEW(); ret_scan_phase(P, ws, l, gtid, gthreads); }
        for (int rep = 0; rep < REP_ATTN; ++rep) { PHASE_VIEW(); attn_phase(P, ws, lds, tid, wave, lane); }
        GSYNC();
        for (int rep = 1; rep < REP_RETO; ++rep) { PHASE_VIEW(); ret_out_phase(P, ws, l, lds, tid, wave, lane, (bf16*)(ws + WS_VT)); }
        { PHASE_VIEW(); ret_out_phase(P, ws, l, lds, tid, wave, lane, (bf16*)(ws + WS_RGS)); }
        GSYNC();
        { PHASE_VIEW(); run_gemm(lds, (const bf16*)(ws + WS_H), (const bf16*)(wa + WA_ING), MT, 3072, DM, 0, EpiBf16{(bf16*)(ws + WS_GF), 3072}); }
        GSYNC();
        { PHASE_VIEW(); run_gemm(lds, (const bf16*)(ws + WS_QKC), (const bf16*)(wa + WA_BA), MT, DM, 512, 0, EpiBf16{(bf16*)(ws + WS_H), DM}); }
        { PHASE_VIEW(); run_gemm(lds, (const bf16*)(ws + WS_RGS), (const bf16*)(wa + WA_BR), MT, DM, 512, 64 % G, EpiBf16{(bf16*)(ws + WS_BF2), DM}); }
        { PHASE_VIEW(); run_gemm(lds, (const bf16*)(ws + WS_YPOOL), (const bf16*)(wa + WA_EFF), MT, DM, 512, 128 % G, EpiBf16{(bf16*)(ws + WS_SG), DM}); }
        GSYNC();
        { PHASE_VIEW(); const u32x2* G3 = (const u32x2*)(ws + WS_GF); const u32x2* B0 = (const u32x2*)(ws + WS_H); const u32x2* B1 = (const u32x2*)(ws + WS_BF2); u32x2* S = (u32x2*)(ws + WS_SG);
#pragma unroll 4
          for (int i = gtid; i < MT * DM / 4; i += gthreads) { const int row = i >> 8, c4 = i & 255; const u32x2* gp = G3 + (size_t)row * 768 + c4;
              const u32x2 ga = gp[0], gb = gp[256], gc = gp[512], ba = B0[i], bb = B1[i], bc = S[i];
              const float y0 = sigmoidf_(bflo(ga.x)) * bflo(ba.x) + sigmoidf_(bflo(gb.x)) * bflo(bb.x) + sigmoidf_(bflo(gc.x)) * bflo(bc.x);
              const float y1 = sigmoidf_(bfhi(ga.x)) * bfhi(ba.x) + sigmoidf_(bfhi(gb.x)) * bfhi(bb.x) + sigmoidf_(bfhi(gc.x)) * bfhi(bc.x);
              const float y2 = sigmoidf_(bflo(ga.y)) * bflo(ba.y) + sigmoidf_(bflo(gb.y)) * bflo(bb.y) + sigmoidf_(bflo(gc.y)) * bflo(bc.y);
              const float y3 = sigmoidf_(bfhi(ga.y)) * bfhi(ba.y) + sigmoidf_(bfhi(gb.y)) * bfhi(bb.y) + sigmoidf_(bfhi(gc.y)) * bfhi(bc.y);
              u32x2 o; o.x = pk(y0, y1); o.y = pk(y2, y3); S[i] = o; }
          conv_job(P.ffn2_d + (size_t)l * DFF * DM, DFF, DM, (bf16*)(ws + WS_W + WA_D), DFF, DM, 0, nullptr, scr, gw, ngw, lane); }
        GSYNC();
        for (int rep = 0; rep < REP_WOUT; ++rep) { PHASE_VIEW(); run_gemm(lds, (const bf16*)(ws + WS_SG), (const bf16*)(wa + WA_OUT), MT, DM, DM, 0, EpiBf16{(bf16*)(ws + WS_YO), DM}); }
        { PHASE_VIEW(); CONV_VIEW(); if (cdo) conv_job(P.ffn2_gu + (size_t)l * DM * 2 * DFF, DM, 2 * DFF, (bf16*)(ws + WS_W + WA_GU), DM, 2 * DFF, 1, nullptr, scr, cgw, cngw, lane); }
        GSYNC();
        { PHASE_VIEW();
          row_phase(P, ws, 1, (const bf16*)(ws + WS_YO), l, 1, 1.0f, l, 2, false, gw, ngw, lane);
        }
        GSYNC();
        ffn_phases(P, xbar, lds, l == 0 ? 2 : 0, l);
        if (l == 0) {
            PHASE_VIEW();
            row_phase(P, ws, 1, (const bf16*)(ws + WS_YF), 0, 2, 0.5f, 1, 0, false, gw, ngw, lane);
            conv_job(P.ffn1_d + (size_t)DFF * DM, DFF, DM, (bf16*)(ws + WS_W + WA_D), DFF, DM, 0, nullptr, scr, gw, ngw, lane);
        } else {
            PHASE_VIEW();
            row_phase(P, ws, 2, (const bf16*)(ws + WS_YF), 1, 2, 0.5f, 0, 0, false, gw, ngw, lane);
        }
        if (l == 0) GSYNC();
    }
}

extern "C" void kernel_launch(void* const* d_in, const int* in_sizes, int n_in, void* d_out, int out_size, void* d_ws, size_t ws_size, hipStream_t stream) {
    static int grid_blocks = 0;
    if (!grid_blocks) {
        if (n_in != 27 || ws_size < WS_END) { fprintf(stderr, "kernel_launch: unexpected n_in %d or ws_size %zu (< %zu)\n", n_in, ws_size, (size_t)WS_END); grid_blocks = -1; return; }
        int dev = 0, cus = 0, per_cu = 0;
        (void)hipGetDevice(&dev);
        (void)hipDeviceGetAttribute(&cus, hipDeviceAttributeMultiprocessorCount, dev);
        if (hipFuncSetAttribute((const void*)fwd_kernel, hipFuncAttributeMaxDynamicSharedMemorySize, LDS_BYTES) != hipSuccess) fprintf(stderr, "kernel_launch: hipFuncSetAttribute failed\n");
        if (hipOccupancyMaxActiveBlocksPerMultiprocessor(&per_cu, (const void*)fwd_kernel, 512, LDS_BYTES) != hipSuccess || per_cu < 1) { per_cu = 1; (void)hipGetLastError(); }
        grid_blocks = cus * per_cu;
    }
    if (grid_blocks < 0) return;
    Params p{};
    const float** pp = (const float**)&p;
    for (int i = 0; i < 27; ++i) pp[i] = (const float*)d_in[i];
    p.out = (float*)d_out; p.ws = (unsigned char*)d_ws;
    (void)hipMemsetAsync((char*)d_ws + WS_BAR, 0, 16 * 1024, stream);
    void* args[] = {&p};
    hipError_t e = hipLaunchCooperativeKernel((const void*)fwd_kernel, dim3(grid_blocks), dim3(512), args, LDS_BYTES, stream);
    if (e != hipSuccess) fprintf(stderr, "cooperative launch failed: %s (grid %d)\n", hipGetErrorString(e), grid_blocks);
}
```
